# Optimizing an MI355X kernel written in HIP

```python
import math
import jax, jax.numpy as jnp
from jax import lax
import numpy as np

D_MODEL = 1024
BATCH = 8
SEQ = 8192
DEPTH = 2

CTX_LEN = 256
GRID_W = 64
D_FF = 2816
N_MOD = 9
ROPE_BASE = 10000.0
Q_BLOCK = 128
NEG_INF = -1e30
EPS = 1e-6
SUBLN_EPS = 1e-5

MLA_HEADS = 4
MLA_Q_RANK = 256
MLA_KV_RANK = 128
MLA_NOPE = 64
MLA_ROPE = 32
MLA_V = 64
MLA_SCALE = (MLA_NOPE + MLA_ROPE) ** -0.5
DIFF_HEADS = 4
DIFF_HEAD = 32
DIFF_V = 2 * DIFF_HEAD
DIFF_SCALE = DIFF_HEAD ** -0.5
NA_HEADS = 4
NA_HEAD = 64
NA_ROWS = 8
NA_COLS = 16
NA_SCALE = NA_HEAD ** -0.5
GQA_HEADS = 4
GQA_KV_HEADS = 2
GQA_HEAD = 64
WINDOW = 128
GQA_SCALE = GQA_HEAD ** -0.5

N_BRANCH = 4
BRANCH_W = 256
DIFF_QK_W = DIFF_HEADS * 2 * DIFF_HEAD
DIFF_V_W = DIFF_HEADS * DIFF_V
NA_W = NA_HEADS * NA_HEAD
GQA_Q_W = GQA_HEADS * GQA_HEAD
GQA_KV_W = GQA_KV_HEADS * GQA_HEAD
IN_SIZES = (MLA_Q_RANK, MLA_KV_RANK, MLA_ROPE,
            DIFF_QK_W, DIFF_QK_W, DIFF_V_W,
            NA_W, NA_W, NA_W,
            GQA_Q_W, GQA_KV_W, GQA_KV_W)
IN_COLS = 2464

kernel_name = "hybrid_parallel_mla_diff_natten_swa_dit"


def rmsnorm(x, g, eps=EPS):
    x32 = x.astype(jnp.float32)
    y = x32 * lax.rsqrt(jnp.mean(x32 * x32, axis=-1, keepdims=True) + eps)
    return (y * g.astype(jnp.float32)).astype(x.dtype)


def modulate(h, g, shift, scale):
    return rmsnorm(h, g) * (1 + scale) + shift


def swiglu(u, w_gu, w_down):
    g, up = jnp.split(u @ w_gu, 2, axis=-1)
    return (jax.nn.silu(g) * up) @ w_down


def softmax_f32(s):
    return jax.nn.softmax(s.astype(jnp.float32), axis=-1)


def axial_angles(n_tok, dim):
    t = jnp.arange(n_tok)
    rows = (t // GRID_W).astype(jnp.float32)
    cols = (t % GRID_W).astype(jnp.float32)
    half = dim // 2
    freqs = jnp.power(ROPE_BASE, -jnp.arange(0, half, 2, dtype=jnp.float32) / half)
    return rows[:, None] * freqs, cols[:, None] * freqs


def rope_1d(x, ang):
    x1, x2 = jnp.split(x, 2, axis=-1)
    cos, sin = jnp.cos(ang), jnp.sin(ang)
    return jnp.concatenate([x1 * cos - x2 * sin, x2 * cos + x1 * sin], axis=-1)


def rope_2d(x, angles):
    ang_r, ang_c = angles
    shape = (ang_r.shape[0],) + (1,) * (x.ndim - 3) + (ang_r.shape[1],)
    x32 = x.astype(jnp.float32)
    d = x.shape[-1]
    out = jnp.concatenate([rope_1d(x32[..., : d // 2], ang_r.reshape(shape)),
                           rope_1d(x32[..., d // 2:], ang_c.reshape(shape))], axis=-1)
    return out.astype(x.dtype)


def attend(q, k, v, scale):
    s = jnp.einsum('bqhd,bkhd->bhqk', q, k) * scale
    p = softmax_f32(s).astype(v.dtype)
    return jnp.einsum('bhqk,bkhe->bqhe', p, v)


def diff_attend(q, k, v, lam, scale):
    s = jnp.einsum('bqhnd,bkhnd->bnhqk', q, k) * scale
    p = softmax_f32(s)
    pd = (p[:, 0] - lam * p[:, 1]).astype(v.dtype)
    return jnp.einsum('bhqk,bkhe->bqhe', pd, v)


def sweep_query_blocks(fn, q):
    B, S = q.shape[:2]
    nb = S // Q_BLOCK
    qb = jnp.moveaxis(q.reshape((B, nb, Q_BLOCK) + q.shape[2:]), 1, 0)
    out = lax.map(fn, qb)
    return jnp.moveaxis(out, 0, 1).reshape((B, S) + out.shape[3:])


def neighbourhood_attend(q, k, v, k_ctx, v_ctx, rpb):
    B, S, H, d = q.shape
    L = k_ctx.shape[1]
    rows = S // GRID_W
    kh = min(NA_ROWS, rows)
    n_cb = GRID_W // NA_COLS
    span = 2 * NA_COLS
    qcols = np.arange(GRID_W).reshape(n_cb, NA_COLS)
    col_start = np.clip(np.arange(n_cb) * NA_COLS - NA_COLS // 2, 0, GRID_W - span)
    kcols = col_start[:, None] + np.arange(span)
    cs = np.clip(qcols - NA_COLS // 2, 0, GRID_W - NA_COLS)
    kc = kcols[:, None, :]
    col_ok = (kc >= cs[..., None]) & (kc < cs[..., None] + NA_COLS)
    dc = kc - qcols[..., None] + (NA_COLS - 1)
    mask = jnp.asarray(np.broadcast_to(col_ok[:, :, None, :], (n_cb, NA_COLS, kh, span))
                       .reshape(n_cb, NA_COLS, kh * span))
    kg = k.reshape(B, rows, GRID_W, H, d)
    vg = v.reshape(B, rows, GRID_W, H, d)
    qg = jnp.moveaxis(q.reshape(B, rows, n_cb, NA_COLS, H, d), 1, 0)

    def row_fn(args):
        r, q_row = args
        rs = jnp.clip(r - kh // 2, 0, rows - kh)
        k_rows = lax.dynamic_slice_in_dim(kg, rs, kh, axis=1)[:, :, kcols]
        v_rows = lax.dynamic_slice_in_dim(vg, rs, kh, axis=1)[:, :, kcols]
        kb = jnp.moveaxis(k_rows, 2, 1).reshape(B, n_cb, kh * span, H, d)
        vb = jnp.moveaxis(v_rows, 2, 1).reshape(B, n_cb, kh * span, H, d)
        dr = rs + jnp.arange(kh) - r + (NA_ROWS - 1)
        bias = rpb[:, dr[None, None, :, None], dc[:, :, None, :]]
        bias = bias.reshape(H, n_cb, NA_COLS, kh * span).astype(jnp.float32)
        s_lat = jnp.einsum('bjqhd,bjkhd->bhjqk', q_row, kb).astype(jnp.float32) * NA_SCALE + bias[None]
        s_lat = jnp.where(mask[None, None], s_lat, NEG_INF)
        s_ctx = jnp.einsum('bjqhd,bkhd->bhjqk', q_row, k_ctx).astype(jnp.float32) * NA_SCALE
        p = softmax_f32(jnp.concatenate([s_ctx, s_lat], axis=-1)).astype(v.dtype)
        return (jnp.einsum('bhjqk,bkhe->bjqhe', p[..., :L], v_ctx)
                + jnp.einsum('bhjqk,bjkhe->bjqhe', p[..., L:], vb))

    out = lax.map(row_fn, (jnp.arange(rows), qg))
    return jnp.moveaxis(out, 0, 1).reshape(B, S, H, d)


def window_attend(q, k, v, k_ctx, v_ctx, sink):
    B, S, H, d = q.shape
    kvh = k.shape[2]
    g = H // kvh
    L = k_ctx.shape[1]
    nb = S // WINDOW
    span = 3 * WINDOW
    pad = ((0, 0), (WINDOW, WINDOW), (0, 0), (0, 0))
    kp, vp = jnp.pad(k, pad), jnp.pad(v, pad)
    qb = jnp.moveaxis(q.reshape(B, nb, WINDOW, kvh, g, d), 1, 0)
    sink_col = jnp.broadcast_to(sink.astype(jnp.float32).reshape(1, kvh, g, 1, 1), (B, kvh, g, WINDOW, 1))

    def blk_fn(args):
        n, q_blk = args
        kb = lax.dynamic_slice_in_dim(kp, n * WINDOW, span, axis=1)
        vb = lax.dynamic_slice_in_dim(vp, n * WINDOW, span, axis=1)
        qpos = n * WINDOW + jnp.arange(WINDOW)
        kpos = n * WINDOW - WINDOW + jnp.arange(span)
        ok = ((jnp.abs(qpos[:, None] - kpos[None, :]) <= WINDOW)
              & (kpos >= 0)[None, :] & (kpos < S)[None, :])
        s_lat = jnp.einsum('bqgrd,bkgd->bgrqk', q_blk, kb).astype(jnp.float32) * GQA_SCALE
        s_lat = jnp.where(ok, s_lat, NEG_INF)
        s_ctx = jnp.einsum('bqgrd,bkgd->bgrqk', q_blk, k_ctx).astype(jnp.float32) * GQA_SCALE
        p = softmax_f32(jnp.concatenate([sink_col, s_ctx, s_lat], axis=-1)).astype(v.dtype)
        o = (jnp.einsum('bgrqk,bkge->bqgre', p[..., 1:1 + L], v_ctx)
             + jnp.einsum('bgrqk,bkge->bqgre', p[..., 1 + L:], vb))
        return o.reshape(B, WINDOW, H, d)

    out = lax.map(blk_fn, (jnp.arange(nb), qb))
    return jnp.moveaxis(out, 0, 1).reshape(B, S, H, d)


def sink_attend(q, k, v, sink):
    B, L, H, d = q.shape
    kvh = k.shape[2]
    g = H // kvh
    qg = q.reshape(B, L, kvh, g, d)
    s = jnp.einsum('bqgrd,bkgd->bgrqk', qg, k).astype(jnp.float32) * GQA_SCALE
    sink_col = jnp.broadcast_to(sink.astype(jnp.float32).reshape(1, kvh, g, 1, 1), (B, kvh, g, L, 1))
    p = softmax_f32(jnp.concatenate([sink_col, s], axis=-1)).astype(v.dtype)
    return jnp.einsum('bgrqk,bkge->bqgre', p[..., 1:], v).reshape(B, L, H, d)


def split_cols(p):
    offs = np.cumsum(IN_SIZES)[:-1].tolist()
    return jnp.split(p, offs, axis=-1)


def mixer_inputs(p, rope, mla_q_norm, mla_w_uq, mla_kv_norm, mla_w_ukv):
    cq, ckv, kr, dq, dk, dv, nq, nk, nv, gq, gk, gv = split_cols(p)
    lead = p.shape[:-1]

    def rot(x, i):
        return x if rope is None else rope_2d(x, rope[i])

    qa = (rmsnorm(cq, mla_q_norm) @ mla_w_uq).reshape(lead + (MLA_HEADS, MLA_NOPE + MLA_ROPE))
    qa = jnp.concatenate([qa[..., :MLA_NOPE], rot(qa[..., MLA_NOPE:], 0)], axis=-1)
    kva = (rmsnorm(ckv, mla_kv_norm) @ mla_w_ukv).reshape(lead + (MLA_HEADS, MLA_NOPE + MLA_V))
    k_rope = rot(kr[..., None, :], 0)
    ka = jnp.concatenate([kva[..., :MLA_NOPE],
                          jnp.broadcast_to(k_rope, lead + (MLA_HEADS, MLA_ROPE))], axis=-1)
    va = kva[..., MLA_NOPE:]
    qb = rot(dq.reshape(lead + (DIFF_HEADS, 2, DIFF_HEAD)), 0)
    kb = rot(dk.reshape(lead + (DIFF_HEADS, 2, DIFF_HEAD)), 0)
    vb = dv.reshape(lead + (DIFF_HEADS, DIFF_V))
    qc = nq.reshape(lead + (NA_HEADS, NA_HEAD))
    kc = nk.reshape(lead + (NA_HEADS, NA_HEAD))
    vc = nv.reshape(lead + (NA_HEADS, NA_HEAD))
    qd = rot(gq.reshape(lead + (GQA_HEADS, GQA_HEAD)), 1)
    kd = rot(gk.reshape(lead + (GQA_KV_HEADS, GQA_HEAD)), 1)
    vd = gv.reshape(lead + (GQA_KV_HEADS, GQA_HEAD))
    return (qa, ka, va, qb, kb, vb, qc, kc, vc, qd, kd, vd)


def gated_merge(u, ys, w_branch, w_gate, b_gate, w_out):
    terms = []
    for i, y in enumerate(ys):
        y = y.reshape(y.shape[:2] + (BRANCH_W,))
        terms.append(jax.nn.sigmoid(u @ w_gate[i] + b_gate[i]) * (y @ w_branch[i]))
    merged = terms[0]
    for t in terms[1:]:
        merged = merged + t
    return merged @ w_out


def token_mix(u_lat, u_ctx, rope, lam_init, w_in, mla_q_norm, mla_w_uq, mla_kv_norm, mla_w_ukv,
              diff_lam, diff_subln, na_rpb, gqa_sink, w_branch, w_gate, b_gate, w_out, ctx_out):
    qa, ka, va, qb, kb, vb, qc, kc, vc, qd, kd, vd = mixer_inputs(
        u_lat @ w_in, rope, mla_q_norm, mla_w_uq, mla_kv_norm, mla_w_ukv)
    qa_c, ka_c, va_c, qb_c, kb_c, vb_c, qc_c, kc_c, vc_c, qd_c, kd_c, vd_c = mixer_inputs(
        u_ctx @ w_in, None, mla_q_norm, mla_w_uq, mla_kv_norm, mla_w_ukv)
    dl = diff_lam.astype(jnp.float32)
    lam = jnp.exp(jnp.sum(dl[0] * dl[1])) - jnp.exp(jnp.sum(dl[2] * dl[3])) + lam_init

    ka_all = jnp.concatenate([ka_c, ka], axis=1)
    va_all = jnp.concatenate([va_c, va], axis=1)
    ya = sweep_query_blocks(lambda qblk: attend(qblk, ka_all, va_all, MLA_SCALE), qa)
    kb_all = jnp.concatenate([kb_c, kb], axis=1)
    vb_all = jnp.concatenate([vb_c, vb], axis=1)
    yb = sweep_query_blocks(lambda qblk: diff_attend(qblk, kb_all, vb_all, lam, DIFF_SCALE), qb)
    yb = rmsnorm(yb, diff_subln, SUBLN_EPS) * (1 - lam_init)
    yc = neighbourhood_attend(qc, kc, vc, kc_c, vc_c, na_rpb)
    yd = window_attend(qd, kd, vd, kd_c, vd_c, gqa_sink)
    y_lat = gated_merge(u_lat, (ya, yb, yc, yd), w_branch, w_gate, b_gate, w_out)
    if not ctx_out:
        return y_lat, None
    ya_c = attend(qa_c, ka_c, va_c, MLA_SCALE)
    yb_c = rmsnorm(diff_attend(qb_c, kb_c, vb_c, lam, DIFF_SCALE), diff_subln, SUBLN_EPS) * (1 - lam_init)
    yc_c = attend(qc_c, kc_c, vc_c, NA_SCALE)
    yd_c = sink_attend(qd_c, kd_c, vd_c, gqa_sink)
    y_ctx = gated_merge(u_ctx, (ya_c, yb_c, yc_c, yd_c), w_branch, w_gate, b_gate, w_out)
    return y_lat, y_ctx


def setup_inputs(seed: int = 0) -> dict:
    key = jax.random.key(seed)
    ks = jax.random.split(key, 32)
    f32 = jnp.float32

    def nrm(k, shape, scale):
        return jax.random.normal(k, shape, f32) * scale

    def gain(k, shape):
        return 1.0 + nrm(k, shape, 0.05)

    D = D_MODEL
    return {
        "x": nrm(ks[0], (BATCH, SEQ, D), 1.0),
        "c": nrm(ks[1], (BATCH, D), 1.0),
        "ctx": nrm(ks[2], (BATCH, CTX_LEN, D), 1.0),
        "c_ctx": nrm(ks[3], (D,), 1.0),
        "w_ada": nrm(ks[4], (DEPTH, D, N_MOD * D), 0.5 * D ** -0.5),
        "b_ada": nrm(ks[5], (DEPTH, N_MOD * D), 0.01),
        "norm_ffn1": gain(ks[6], (DEPTH, D)),
        "ffn1_w_gu": nrm(ks[7], (DEPTH, D, 2 * D_FF), D ** -0.5),
        "ffn1_w_down": nrm(ks[8], (DEPTH, D_FF, D), D_FF ** -0.5),
        "norm_mix": gain(ks[9], (DEPTH, D)),
        "w_in": nrm(ks[10], (DEPTH, D, IN_COLS), D ** -0.5),
        "mla_q_norm": gain(ks[11], (DEPTH, MLA_Q_RANK)),
        "mla_w_uq": nrm(ks[12], (DEPTH, MLA_Q_RANK, MLA_HEADS * (MLA_NOPE + MLA_ROPE)), MLA_Q_RANK ** -0.5),
        "mla_kv_norm": gain(ks[13], (DEPTH, MLA_KV_RANK)),
        "mla_w_ukv": nrm(ks[14], (DEPTH, MLA_KV_RANK, MLA_HEADS * (MLA_NOPE + MLA_V)), MLA_KV_RANK ** -0.5),
        "diff_lam": nrm(ks[15], (DEPTH, 4, DIFF_HEAD), 0.1),
        "diff_subln": gain(ks[16], (DEPTH, DIFF_V)),
        "na_rpb": nrm(ks[17], (DEPTH, NA_HEADS, 2 * NA_ROWS - 1, 2 * NA_COLS - 1), 0.1),
        "gqa_sink": nrm(ks[18], (DEPTH, GQA_HEADS), 0.5),
        "w_branch": nrm(ks[19], (DEPTH, N_BRANCH, BRANCH_W, D), BRANCH_W ** -0.5),
        "w_gate": nrm(ks[20], (DEPTH, N_BRANCH, D, D), D ** -0.5),
        "b_gate": nrm(ks[21], (DEPTH, N_BRANCH, D), 0.01),
        "w_out": nrm(ks[22], (DEPTH, D, D), D ** -0.5),
        "norm_ffn2": gain(ks[23], (DEPTH, D)),
        "ffn2_w_gu": nrm(ks[24], (DEPTH, D, 2 * D_FF), D ** -0.5),
        "ffn2_w_down": nrm(ks[25], (DEPTH, D_FF, D), D_FF ** -0.5),
        "final_norm": gain(ks[26], (D,)),
    }


def reference(x, c, ctx, c_ctx, w_ada, b_ada, norm_ffn1, ffn1_w_gu, ffn1_w_down, norm_mix, w_in,
              mla_q_norm, mla_w_uq, mla_kv_norm, mla_w_ukv, diff_lam, diff_subln, na_rpb, gqa_sink,
              w_branch, w_gate, b_gate, w_out, norm_ffn2, ffn2_w_gu, ffn2_w_down, final_norm):
    B, S, D = x.shape
    rope = (axial_angles(S, MLA_ROPE), axial_angles(S, GQA_HEAD))
    s_c = jax.nn.silu(c)
    s_cc = jax.nn.silu(c_ctx)
    h, hc = x, ctx
    for l in range(DEPTH):
        last = l == DEPTH - 1
        lam_init = 0.8 - 0.6 * math.exp(-0.3 * l)
        mod = (s_c @ w_ada[l] + b_ada[l]).reshape(B, N_MOD, 1, D)
        mod_c = (s_cc @ w_ada[l] + b_ada[l]).reshape(N_MOD, D)
        h = h + 0.5 * mod[:, 2] * swiglu(modulate(h, norm_ffn1[l], mod[:, 0], mod[:, 1]),
                                         ffn1_w_gu[l], ffn1_w_down[l])
        hc = hc + 0.5 * mod_c[2] * swiglu(modulate(hc, norm_ffn1[l], mod_c[0], mod_c[1]),
                                          ffn1_w_gu[l], ffn1_w_down[l])
        u = modulate(h, norm_mix[l], mod[:, 3], mod[:, 4])
        uc = modulate(hc, norm_mix[l], mod_c[3], mod_c[4])
        y, yc = token_mix(u, uc, rope, lam_init, w_in[l], mla_q_norm[l], mla_w_uq[l], mla_kv_norm[l],
                          mla_w_ukv[l], diff_lam[l], diff_subln[l], na_rpb[l], gqa_sink[l],
                          w_branch[l], w_gate[l], b_gate[l], w_out[l], not last)
        h = h + mod[:, 5] * y
        h = h + 0.5 * mod[:, 8] * swiglu(modulate(h, norm_ffn2[l], mod[:, 6], mod[:, 7]),
                                         ffn2_w_gu[l], ffn2_w_down[l])
        if not last:
            hc = hc + mod_c[5] * yc
            hc = hc + 0.5 * mod_c[8] * swiglu(modulate(hc, norm_ffn2[l], mod_c[6], mod_c[7]),
                                              ffn2_w_gu[l], ffn2_w_down[l])
    return rmsnorm(h, final_norm)
```

```cpp
#include <hip/hip_runtime.h>
#include <hip/hip_cooperative_groups.h>
#include <cstdint>
#include <cstdio>
namespace cg = cooperative_groups;

#define LAS __attribute__((address_space(3)))
#define DI __device__ __forceinline__
#define GAS __attribute__((address_space(1)))
typedef unsigned short bf16_t;
typedef short bf16x8 __attribute__((ext_vector_type(8)));
typedef short s16x4 __attribute__((ext_vector_type(4)));
typedef float f32x2 __attribute__((ext_vector_type(2)));
typedef float f32x4 __attribute__((ext_vector_type(4)));
typedef float f32x16 __attribute__((ext_vector_type(16)));
typedef unsigned u32x2 __attribute__((ext_vector_type(2)));
typedef unsigned u32x4 __attribute__((ext_vector_type(4)));
typedef __bf16 bf16x2_t __attribute__((ext_vector_type(2)));

constexpr int DM = 1024, NB = 8, SEQ = 8192, CTX = 256, DFF = 2816;
constexpr int MLAT = NB * SEQ, MCTX = NB * CTX, MALL = MLAT + MCTX;
constexpr int INP = 2560;
constexpr int NWAVES = 8, NTHR = 512;
constexpr float LOG2E = 1.4426950408889634f;
constexpr float SC_A = 0.10206207261596575f * LOG2E;
constexpr float SC_B = 0.17677669529663687f * LOG2E;
constexpr float SC_C = 0.125f * LOG2E;
constexpr float SC_D = 0.125f * LOG2E;
constexpr int C_CQ = 0, C_CKV = 256, C_KR = 384, C_DQ = 416, C_DK = 672, C_DV = 928, C_NQ = 1184, C_NK = 1440, C_NV = 1696, C_GQ = 1952, C_GK = 2208, C_GV = 2336, C_END = 2464;

constexpr size_t MiB = 1u << 20;
constexpr size_t WS_MOD = 0;
constexpr size_t WS_TAB = 1 * MiB;
constexpr size_t WS_W = 2 * MiB, WL = 51 * MiB;
constexpr size_t W_GU1 = 0, W_DN1 = 11 * MiB, W_GU2 = 16 * MiB + MiB / 2, W_DN2 = 27 * MiB + MiB / 2, W_IN = 33 * MiB, W_MLA = 38 * MiB,
                 W_GATE = 38 * MiB + 3 * MiB / 4, W_BR = 46 * MiB + 3 * MiB / 4, W_OUT = 48 * MiB + 3 * MiB / 4;
constexpr size_t WS_HC = 104 * MiB;
constexpr size_t WS_U = 112 * MiB;
constexpr size_t WS_S = 244 * MiB;
constexpr size_t S_P = 0, S_R = 330 * MiB, S_DER = 462 * MiB;
constexpr size_t S_FFH = 0, S_Y = S_R, S_BR = 0, S_MG = S_DER;
constexpr size_t D_QA = 0, D_KA = (size_t)MALL * 768, D_VA = D_KA + (size_t)MALL * 768, D_QB = D_VA + (size_t)MALL * 512, D_KB = D_QB + (size_t)MALL * 512,
                 D_QD = D_KB + (size_t)MALL * 512, D_KD = D_QD + (size_t)MALL * 512;
constexpr size_t WS_END = WS_S + 726 * MiB;

DI float bf2f(bf16_t u) { return __uint_as_float((unsigned)u << 16); }
DI unsigned f2bf(float f) { unsigned u = __float_as_uint(f); return (u + 0x7fffu + ((u >> 16) & 1u)) >> 16; }
DI unsigned pk2(float lo, float hi) { f32x2 v = {lo, hi}; bf16x2_t b = __builtin_convertvector(v, bf16x2_t); return __builtin_bit_cast(unsigned, b); }
DI float wave_sum(float v) {
#pragma unroll
    for (int o = 1; o < 64; o <<= 1) v += __shfl_xor(v, o);
    return v;
}
DI int opaque_tid() { int t = threadIdx.x; asm volatile("" : "+v"(t)); return t; }
DI int opaque_bid() { int t = blockIdx.x; asm volatile("" : "+s"(t)); return t; }
DI float fast_exp2(float x) { return __builtin_amdgcn_exp2f(x); }
DI float fast_rcp(float x) { return __builtin_amdgcn_rcpf(x); }


constexpr int CTLO = 131072, CTL_EPI = CTLO + 256;
DI unsigned long long lds_u64(LAS unsigned char* lds, int off) { const volatile LAS unsigned* p = (const volatile LAS unsigned*)(lds + off);
    const unsigned lo = __builtin_amdgcn_readfirstlane(p[0]), hi = __builtin_amdgcn_readfirstlane(p[1]); return ((unsigned long long)hi << 32) | lo; }
DI unsigned lds_u32(LAS unsigned char* lds, int off) { const volatile LAS unsigned* p = (const volatile LAS unsigned*)(lds + off); return __builtin_amdgcn_readfirstlane(p[0]); }
#define INP_(k) ((const float*)lds_u64(lds, CTLO + 8 * (k)))
#define OUTP_ ((float*)lds_u64(lds, CTLO + 8 * 27))
#define WSP_ ((unsigned char*)lds_u64(lds, CTLO + 8 * 28))

namespace pg8 {
constexpr int BM = 256, BK = 64, HALF = 128, HTB = HALF * BK * 2, STAGE_BYTES = 8 * HTB, NXCD = 8, WGM = 8;
DI int lds_byte(int r, int c) { const int st = (r >> 4) * 2 + (c >> 5), rr = r & 15, cc = c & 31, ob = rr * 64 + cc * 2; return st * 1024 + (ob ^ (((ob >> 9) & 1) << 5)); }
DI void stage_rc(int b, int& R, int& C) { const int st = b / 1024, sb = b % 1024, swz = sb ^ (((sb >> 9) & 1) << 5); R = (st >> 1) * 16 + swz / 64; C = (st & 1) * 32 + (swz % 64) / 2; }
DI int perm32(int rho) { const int n = rho >> 4, i = rho & 15; return 8 * (i >> 2) + 4 * n + (i & 3); }
struct Unit { int pm, pn; };
struct Gemm { const bf16_t* A; const bf16_t* Bt; int M, N, K, lda; };
struct StaticOrder {
    int nM, nN, nwg, G, c;
    DI void init(int M, int N, int G_, int c_) { nM = M / BM; nN = N / BM; nwg = nM * nN; G = G_; c = c_; }
    DI bool next(int i, Unit& u) const {
        const long L = (long)i * G + c; if (L >= nwg) return false;
        int wgid = (int)L; { const int q = nwg / NXCD, r = nwg % NXCD, xcd = wgid % NXCD, off = wgid / NXCD; wgid = (xcd < r ? xcd * (q + 1) : r * (q + 1) + (xcd - r) * q) + off; }
        const int nig = WGM * nN, gid = wgid / nig, fm = gid * WGM, gsz = (nM - fm) < WGM ? (nM - fm) : WGM;
        u.pm = fm + ((wgid % nig) % gsz); u.pn = (wgid % nig) / gsz; return true;
    }
};

struct Epi {
    int mode; bool perm;
    bf16_t* O; int ldc;
    const float* base_lat; const float* base_ctx; float* out_lat; float* out_ctx; const float* modp; int gate_chunk; float gs;
    const float* bias; bf16_t* BR; bf16_t* MG; int gi;
    int row_off;
    DI void operator()(const f32x4 (&acc)[2][2][4][2], const Unit& u, int wr, int wc, int fr, int fq) const {
        const int row0 = row_off + u.pm * BM + wr * 64 + fr;
        if (mode == 0) {
            const int col0 = u.pn * BM + wc * 64 + 8 * fq;
#pragma unroll
            for (int ai = 0; ai < 2; ++ai)
#pragma unroll
                for (int m = 0; m < 4; ++m) { bf16_t* rowp = O + (size_t)(row0 + ai * HALF + m * 16) * ldc + col0;
#pragma unroll
                    for (int bj = 0; bj < 2; ++bj) { const f32x4 v0 = acc[ai][bj][m][0], v1 = acc[ai][bj][m][1];
                        u32x4 w; w.x = pk2(v0[0], v0[1]); w.y = pk2(v0[2], v0[3]); w.z = pk2(v1[0], v1[1]); w.w = pk2(v1[2], v1[3]);
                        *(GAS u32x4*)(rowp + bj * 32) = w; } }
        } else if (mode == 1) {
            const int col0 = u.pn * (BM / 2) + wc * 32 + 8 * fq;
#pragma unroll
            for (int ai = 0; ai < 2; ++ai)
#pragma unroll
                for (int m = 0; m < 4; ++m) { bf16_t* rowp = O + (size_t)(row0 + ai * HALF + m * 16) * ldc + col0; float o[8];
#pragma unroll
                    for (int n = 0; n < 2; ++n) { const f32x4 g = acc[ai][0][m][n], up = acc[ai][1][m][n];
#pragma unroll
                        for (int j = 0; j < 4; ++j) o[4 * n + j] = g[j] * fast_rcp(1.0f + fast_exp2(-g[j] * LOG2E)) * up[j]; }
                    u32x4 w; w.x = pk2(o[0], o[1]); w.y = pk2(o[2], o[3]); w.z = pk2(o[4], o[5]); w.w = pk2(o[6], o[7]);
                    *(GAS u32x4*)rowp = w; }
        } else if (mode == 2) {
            const int rowt = row_off + u.pm * BM; const bool lat = rowt < MLAT;
            const int vec = lat ? (rowt >> 13) : 8;
            const float* bp = lat ? base_lat : base_ctx - (size_t)MLAT * DM; float* op = lat ? out_lat : out_ctx - (size_t)MLAT * DM;
            const float* mrow = modp + (size_t)vec * 9216 + gate_chunk * 1024;
            const int col0 = u.pn * BM + wc * 64 + 4 * fq;
            f32x4 gv[2][2];
#pragma unroll
            for (int bj = 0; bj < 2; ++bj)
#pragma unroll
                for (int n = 0; n < 2; ++n) gv[bj][n] = *(const GAS f32x4*)(mrow + col0 + bj * 32 + n * 16) * gs;
#pragma unroll
            for (int ai = 0; ai < 2; ++ai)
#pragma unroll
                for (int mh = 0; mh < 2; ++mh) { f32x4 b[2][2][2];
#pragma unroll
                    for (int mm = 0; mm < 2; ++mm) { const size_t off = (size_t)(row0 + ai * HALF + (2 * mh + mm) * 16) * DM + col0;
#pragma unroll
                        for (int bj = 0; bj < 2; ++bj)
#pragma unroll
                            for (int n = 0; n < 2; ++n) b[mm][bj][n] = *(const GAS f32x4*)(bp + off + bj * 32 + n * 16); }
#pragma unroll
                    for (int mm = 0; mm < 2; ++mm) { const size_t off = (size_t)(row0 + ai * HALF + (2 * mh + mm) * 16) * DM + col0;
#pragma unroll
                        for (int bj = 0; bj < 2; ++bj)
#pragma unroll
                            for (int n = 0; n < 2; ++n) *(GAS f32x4*)(op + off + bj * 32 + n * 16) = b[mm][bj][n] + gv[bj][n] * acc[ai][bj][2 * mh + mm][n]; } }
        } else {
            const int col0 = u.pn * BM + wc * 64 + 8 * fq;
            f32x4 bb[2][2];
#pragma unroll
            for (int bj = 0; bj < 2; ++bj) { bb[bj][0] = *(const GAS f32x4*)(bias + col0 + bj * 32); bb[bj][1] = *(const GAS f32x4*)(bias + col0 + bj * 32 + 4); }
#pragma unroll
            for (int ai = 0; ai < 2; ++ai)
#pragma unroll
                for (int mh = 0; mh < 2; ++mh) {
                    u32x4 brv[2][2], mgv[2][2];
#pragma unroll
                    for (int mm = 0; mm < 2; ++mm)
#pragma unroll
                        for (int bj = 0; bj < 2; ++bj) { const size_t o_ = (size_t)(row0 + ai * HALF + (2 * mh + mm) * 16) * DM + col0 + bj * 32;
                            brv[mm][bj] = *(const GAS u32x4*)(BR + o_); mgv[mm][bj] = (gi > 0) ? *(const GAS u32x4*)(MG + o_) : (u32x4){0, 0, 0, 0}; }
#pragma unroll
                  for (int mm = 0; mm < 2; ++mm) { const int m = 2 * mh + mm; const size_t offb = (size_t)(row0 + ai * HALF + m * 16) * DM + col0;
#pragma unroll
                    for (int bj = 0; bj < 2; ++bj) { const size_t off = offb + bj * 32; const u32x4 br = brv[mm][bj], mg = mgv[mm][bj];
                        f32x4 x0 = acc[ai][bj][m][0] + bb[bj][0], x1 = acc[ai][bj][m][1] + bb[bj][1]; float v[8];
                        const float bv[8] = {__uint_as_float(br.x << 16), __uint_as_float(br.x & 0xffff0000u), __uint_as_float(br.y << 16), __uint_as_float(br.y & 0xffff0000u),
                                             __uint_as_float(br.z << 16), __uint_as_float(br.z & 0xffff0000u), __uint_as_float(br.w << 16), __uint_as_float(br.w & 0xffff0000u)};
#pragma unroll
                        for (int j = 0; j < 4; ++j) { v[j] = fast_rcp(1.0f + fast_exp2(-x0[j] * LOG2E)) * bv[j]; v[4 + j] = fast_rcp(1.0f + fast_exp2(-x1[j] * LOG2E)) * bv[4 + j]; }
                        v[0] += __uint_as_float(mg.x << 16); v[1] += __uint_as_float(mg.x & 0xffff0000u); v[2] += __uint_as_float(mg.y << 16); v[3] += __uint_as_float(mg.y & 0xffff0000u);
                        v[4] += __uint_as_float(mg.z << 16); v[5] += __uint_as_float(mg.z & 0xffff0000u); v[6] += __uint_as_float(mg.w << 16); v[7] += __uint_as_float(mg.w & 0xffff0000u);
                        u32x4 w; w.x = pk2(v[0], v[1]); w.y = pk2(v[2], v[3]); w.z = pk2(v[4], v[5]); w.w = pk2(v[6], v[7]);
                        if (gi < 3) *(GAS u32x4*)(MG + off) = w; else *(GAS u32x4*)(BR + off) = w; } } }
        }
    }
};

struct EpiL { unsigned mode, perm, ldc, gate_chunk, gi; float gs; unsigned long long O, base_lat, base_ctx, out_lat, out_ctx, modp, bias, BR, MG; unsigned row_off, pad_; };
DI void epi_store(LAS unsigned char* lds, const Epi& e) {
    volatile LAS EpiL* p = (volatile LAS EpiL*)(lds + CTL_EPI);
    p->mode = e.mode; p->perm = e.perm ? 1u : 0u; p->ldc = e.ldc; p->gate_chunk = e.gate_chunk; p->gi = e.gi; p->gs = e.gs;
    p->O = (unsigned long long)e.O; p->base_lat = (unsigned long long)e.base_lat; p->base_ctx = (unsigned long long)e.base_ctx; p->out_lat = (unsigned long long)e.out_lat;
    p->out_ctx = (unsigned long long)e.out_ctx; p->modp = (unsigned long long)e.modp; p->bias = (unsigned long long)e.bias; p->BR = (unsigned long long)e.BR; p->MG = (unsigned long long)e.MG; p->row_off = (unsigned)e.row_off;
}
DI Epi epi_load(LAS unsigned char* lds) {
    Epi e; constexpr int B = CTL_EPI;
    e.mode = (int)lds_u32(lds, B + 0); e.perm = lds_u32(lds, B + 4) != 0u; e.ldc = (int)lds_u32(lds, B + 8); e.gate_chunk = (int)lds_u32(lds, B + 12); e.gi = (int)lds_u32(lds, B + 16);
    e.gs = __uint_as_float(lds_u32(lds, B + 20));
    e.O = (bf16_t*)lds_u64(lds, B + 24); e.base_lat = (const float*)lds_u64(lds, B + 32); e.base_ctx = (const float*)lds_u64(lds, B + 40); e.out_lat = (float*)lds_u64(lds, B + 48);
    e.out_ctx = (float*)lds_u64(lds, B + 56); e.modp = (const float*)lds_u64(lds, B + 64); e.bias = (const float*)lds_u64(lds, B + 72); e.BR = (bf16_t*)lds_u64(lds, B + 80); e.MG = (bf16_t*)lds_u64(lds, B + 88); e.row_off = (int)lds_u32(lds, B + 96);
    return e;
}

DI void gemm_phase(LAS unsigned char* lds, const Gemm g, const StaticOrder& S, const bool eperm) {
    const int tid = opaque_tid(), wid = __builtin_amdgcn_readfirstlane(tid >> 6), lane = tid & 63, wr = wid >> 2, wc = wid & 3, fr = lane & 15, fq = lane >> 4;
    const int K = g.K, nt = K / BK, lda = g.lda;
    unsigned voffA[2], voffB[2];
#pragma unroll
    for (int i = 0; i < 2; ++i) { int R, C; stage_rc(tid * 16 + i * 8192, R, C); const int Rb = 64 * (R >> 5) + (eperm ? perm32(R & 31) : (R & 31));
        voffA[i] = (unsigned)(R * lda + C) * 2u; voffB[i] = (unsigned)(Rb * K + C) * 2u; }
    const size_t kstep = (size_t)(BK * 2);
    const size_t hstepA = (size_t)HALF * lda * 2, tstepA = 2 * hstepA, hstepB = (size_t)32 * K * 2, tstepB = (size_t)BM * K * 2;
    const unsigned ldsw = (unsigned)wid * 1024u;
    const int aoff = lds_byte(wr * 64 + fr, fq * 8), boff = lds_byte(wc * 32 + fr, fq * 8);
#define PG8_SA(b, h) (((b) * 2 + (h)) * HTB)
#define PG8_SB(b, h) ((4 + (b) * 2 + (h)) * HTB)
#define PG8_STAGE(bufoff, gbase, voff) do { _Pragma("unroll") for (int _i = 0; _i < 2; ++_i) \
        __builtin_amdgcn_global_load_lds((const unsigned*)((const char*)(gbase) + (voff)[_i]), (LAS unsigned*)(lds + (bufoff) + ldsw + _i * 8192), 16, 0, 0); } while (0)
#define PG8_LDA(dst, b, h) do { _Pragma("unroll") for (int m = 0; m < 4; ++m) _Pragma("unroll") for (int k = 0; k < 2; ++k) dst[m][k] = *(const LAS bf16x8*)(lds + PG8_SA(b, h) + aoff + m * 2048 + k * 1024); } while (0)
#define PG8_LDB(dst, b, h) do { _Pragma("unroll") for (int n = 0; n < 2; ++n) _Pragma("unroll") for (int k = 0; k < 2; ++k) dst[n][k] = *(const LAS bf16x8*)(lds + PG8_SB(b, h) + boff + n * 2048 + k * 1024); } while (0)
#define PG8_MMA(ai, bj, At, Bt) do { __builtin_amdgcn_s_setprio(1); _Pragma("unroll") for (int m = 0; m < 4; ++m) _Pragma("unroll") for (int n = 0; n < 2; ++n) _Pragma("unroll") for (int k = 0; k < 2; ++k) \
        acc[ai][bj][m][n] = __builtin_amdgcn_mfma_f32_16x16x32_bf16(Bt[n][k], At[m][k], acc[ai][bj][m][n], 0, 0, 0); __builtin_amdgcn_s_setprio(0); } while (0)
#define PG8_WAIT_V(n) asm volatile("s_waitcnt vmcnt(" #n ")" ::: "memory")
#define PG8_WAIT_L(n) asm volatile("s_waitcnt lgkmcnt(" #n ")" ::: "memory")
#define PG8_BAR __builtin_amdgcn_s_barrier()
#define PG8_SCHED __builtin_amdgcn_sched_barrier(0)
    Unit cur, nxt; int ui = 0;
    if (!S.next(0, cur)) return;
    f32x4 acc[2][2][4][2];
#pragma unroll
    for (int a = 0; a < 2; ++a)
#pragma unroll
        for (int b = 0; b < 2; ++b)
#pragma unroll
            for (int m = 0; m < 4; ++m)
#pragma unroll
                for (int n = 0; n < 2; ++n) acc[a][b][m][n] = (f32x4){0.f, 0.f, 0.f, 0.f};
    bf16x8 At[4][2], B0[2][2], B1[2][2];
    const char* cA = (const char*)g.A + (size_t)cur.pm * tstepA; const char* cB = (const char*)g.Bt + (size_t)cur.pn * tstepB;
    PG8_STAGE(PG8_SB(0, 0), cB, voffB); PG8_STAGE(PG8_SB(0, 1), cB + hstepB, voffB); PG8_STAGE(PG8_SA(0, 0), cA, voffA); PG8_STAGE(PG8_SA(0, 1), cA + hstepA, voffA);
    if (wr == 1) PG8_BAR;
    PG8_WAIT_V(2); PG8_BAR;
    PG8_STAGE(PG8_SB(1, 0), cB + kstep, voffB); PG8_STAGE(PG8_SA(1, 0), cA + kstep, voffA); PG8_STAGE(PG8_SB(1, 1), cB + hstepB + kstep, voffB);
    PG8_WAIT_V(6); PG8_BAR;
    for (;;) {
        const bool has_next = S.next(ui + 1, nxt);
        const char* nA = has_next ? (const char*)g.A + (size_t)nxt.pm * tstepA : cA; const char* nB = has_next ? (const char*)g.Bt + (size_t)nxt.pn * tstepB : cB;
        for (int t = 0; t < nt; t += 2) {
            const bool last = (t == nt - 2);
            const char* a1 = cA + (size_t)(t + 1) * kstep;
            const char* a2 = last ? nA : cA + (size_t)(t + 2) * kstep; const char* b2 = last ? nB : cB + (size_t)(t + 2) * kstep;
            const char* a3 = a2 + kstep; const char* b3 = b2 + kstep;
            PG8_LDB(B0, 0, 0); PG8_LDB(B1, 0, 1); PG8_SCHED; PG8_LDA(At, 0, 0); PG8_STAGE(PG8_SA(1, 1), a1 + hstepA, voffA);
            PG8_WAIT_V(8); PG8_WAIT_L(0); PG8_BAR; PG8_MMA(0, 0, At, B0); PG8_MMA(0, 1, At, B1); PG8_BAR; PG8_SCHED;
            PG8_LDA(At, 0, 1); PG8_STAGE(PG8_SB(0, 0), b2, voffB); PG8_STAGE(PG8_SB(0, 1), b2 + hstepB, voffB); PG8_STAGE(PG8_SA(0, 0), a2, voffA);
            PG8_WAIT_V(8); PG8_WAIT_L(0); PG8_BAR; PG8_MMA(1, 0, At, B0); PG8_MMA(1, 1, At, B1); PG8_BAR; PG8_SCHED;
            PG8_LDB(B0, 1, 0); PG8_LDB(B1, 1, 1); PG8_SCHED; PG8_LDA(At, 1, 0); PG8_STAGE(PG8_SA(0, 1), a2 + hstepA, voffA);
            PG8_WAIT_V(8); PG8_WAIT_L(0); PG8_BAR; PG8_MMA(0, 0, At, B0); PG8_MMA(0, 1, At, B1); PG8_BAR; PG8_SCHED;
            PG8_LDA(At, 1, 1); PG8_STAGE(PG8_SB(1, 0), b3, voffB); PG8_STAGE(PG8_SB(1, 1), b3 + hstepB, voffB); PG8_STAGE(PG8_SA(1, 0), a3, voffA);
            PG8_WAIT_V(8); PG8_WAIT_L(0); PG8_BAR; PG8_MMA(1, 0, At, B0); PG8_MMA(1, 1, At, B1); PG8_BAR; PG8_SCHED;
        }
        if (wr == 0) PG8_BAR;
        { const Epi E = epi_load(lds); E(acc, cur, wr, wc, fr, fq); }
        if (!has_next) break;
#pragma unroll
        for (int a = 0; a < 2; ++a)
#pragma unroll
            for (int b = 0; b < 2; ++b)
#pragma unroll
                for (int m = 0; m < 4; ++m)
#pragma unroll
                    for (int n = 0; n < 2; ++n) acc[a][b][m][n] = (f32x4){0.f, 0.f, 0.f, 0.f};
        cur = nxt; cA = nA; cB = nB; ++ui;
        if (wr == 1) PG8_BAR;
    }
    PG8_WAIT_V(0);
    PG8_BAR;
#undef PG8_SA
#undef PG8_SB
#undef PG8_STAGE
#undef PG8_LDA
#undef PG8_LDB
#undef PG8_MMA
#undef PG8_WAIT_V
#undef PG8_WAIT_L
#undef PG8_BAR
#undef PG8_SCHED
}
}

struct AttnU {
    const bf16_t* Q; const bf16_t* K; const bf16_t* V; bf16_t* Y;
    int qs, ks, vs, ys;
    int b, lt0, lt1;
    int q0;
    float m0, l0;
    const float* rpb;
    float lam, post; const float* subln;
};
DI int crow(int i, int h) { return (i & 3) + 8 * (i >> 2) + 4 * h; }

template <int DQK, int NMAP>
DI void att_qk(const LAS unsigned char* Kb, int r, int h, const bf16x8 (&qfm)[DQK / NMAP / 16], int mp, f32x16 (&S)[2]) {
    constexpr int DQM = DQK / NMAP, NKS = DQM / 16, KP = DQK * 2 + 16, CH = (NKS > 4) ? 3 : NKS;
    const LAS unsigned char* kp = Kb + r * KP + (mp * DQM + 8 * h) * 2;
    const f32x16 z = {0.f, 0.f, 0.f, 0.f, 0.f, 0.f, 0.f, 0.f, 0.f, 0.f, 0.f, 0.f, 0.f, 0.f, 0.f, 0.f};
#pragma unroll
    for (int c = 0; c < NKS / CH; ++c) {
        bf16x8 kf[2 * CH];
#pragma unroll
        for (int s = 0; s < CH; ++s) { kf[2 * s] = *(const LAS bf16x8*)(kp + 32 * (c * CH + s)); kf[2 * s + 1] = *(const LAS bf16x8*)(kp + 32 * KP + 32 * (c * CH + s)); }
        __builtin_amdgcn_sched_barrier(0);
        __builtin_amdgcn_s_setprio(1);
#pragma unroll
        for (int s = 0; s < CH; ++s) {
            if (c == 0 && s == 0) { S[0] = __builtin_amdgcn_mfma_f32_32x32x16_bf16(kf[0], qfm[0], z, 0, 0, 0); S[1] = __builtin_amdgcn_mfma_f32_32x32x16_bf16(kf[1], qfm[0], z, 0, 0, 0); }
            else { S[0] = __builtin_amdgcn_mfma_f32_32x32x16_bf16(kf[2 * s], qfm[c * CH + s], S[0], 0, 0, 0); S[1] = __builtin_amdgcn_mfma_f32_32x32x16_bf16(kf[2 * s + 1], qfm[c * CH + s], S[1], 0, 0, 0); }
        }
        __builtin_amdgcn_s_setprio(0);
        __builtin_amdgcn_sched_barrier(0);
    }
}
struct MaskP { int lt, qrow, qcol, rs, cs, qpos; const LAS float* rpbl; };
template <int MODE>
DI void att_sm_head(f32x16 (&S)[2], float& mrefm, float& lrunm, f32x16 (&om)[2], bool latent, const MaskP& mk, int h) {
    {
        f32x16& s0 = S[0]; f32x16& s1 = S[1];
        if (MODE == 1 && latent) {
            const LAS float* rl = mk.rpbl + (mk.lt - mk.qrow + 7) * 31 + (15 - mk.qcol);
#pragma unroll
            for (int i = 0; i < 16; ++i) { const int kc = crow(i, h);
                { const bool ok = (kc >= mk.cs) && (kc < mk.cs + 16); const float bz = rl[ok ? kc : mk.qcol]; s0[i] = ok ? s0[i] + bz : -1e30f; }
                { const int kc2 = kc + 32; const bool ok = (kc2 >= mk.cs) && (kc2 < mk.cs + 16); const float bz = rl[ok ? kc2 : mk.qcol]; s1[i] = ok ? s1[i] + bz : -1e30f; } }
        }
        if (MODE == 2 && latent) {
            const int kb = 64 * mk.lt;
#pragma unroll
            for (int i = 0; i < 16; ++i) { const int d0 = kb + crow(i, h) - mk.qpos, d1 = d0 + 32;
                if (d0 > 128 || d0 < -128) s0[i] = -1e30f; if (d1 > 128 || d1 < -128) s1[i] = -1e30f; }
        }
        float ma = fmaxf(fmaxf(s0[0], s0[1]), s0[2]), mb = fmaxf(fmaxf(s1[0], s1[1]), s1[2]);
#pragma unroll
        for (int i = 3; i < 15; i += 2) { ma = fmaxf(fmaxf(ma, s0[i]), s0[i + 1]); mb = fmaxf(fmaxf(mb, s1[i]), s1[i + 1]); }
        ma = fmaxf(fmaxf(ma, s0[15]), fmaxf(mb, s1[15]));
        { auto rr = __builtin_amdgcn_permlane32_swap(__float_as_uint(ma), __float_as_uint(ma), false, false); ma = fmaxf(__uint_as_float(rr[0]), __uint_as_float(rr[1])); }
        const bool uninit = mrefm < -1e29f;
        const bool need = uninit || (ma - mrefm > 8.0f);
        if (__any(need)) {
            const float mnew = need ? ma : mrefm;
            const float f = uninit ? 1.0f : fast_exp2(mrefm - mnew);
            mrefm = mnew; lrunm *= f;
#pragma unroll
            for (int e = 0; e < 2; ++e)
#pragma unroll
                for (int i = 0; i < 16; ++i) om[e][i] *= f;
        }
    }
}
DI void att_sm_tail(f32x16 (&S)[2], bf16x8 (&pkm)[2][2], const float mrefm, float& lrunm) {
    {
        f32x16& s0 = S[0]; f32x16& s1 = S[1];
        const f32x2 nm2 = {-mrefm, -mrefm};
        f32x2 acc2 = {0.f, 0.f};
#pragma unroll
        for (int i = 0; i < 16; i += 2) {
            f32x2 a = {s0[i], s0[i + 1]}, b = {s1[i], s1[i + 1]}; a += nm2; b += nm2;
            a.x = fast_exp2(a.x); a.y = fast_exp2(a.y); b.x = fast_exp2(b.x); b.y = fast_exp2(b.y);
            acc2 += a; acc2 += b; s0[i] = a.x; s0[i + 1] = a.y; s1[i] = b.x; s1[i + 1] = b.y;
        }
        lrunm += acc2.x + acc2.y;
#pragma unroll
        for (int s = 0; s < 2; ++s) {
            u32x4 w0, w1;
            w0.x = pk2(s0[8 * s + 0], s0[8 * s + 1]); w0.y = pk2(s0[8 * s + 2], s0[8 * s + 3]); w0.z = pk2(s0[8 * s + 4], s0[8 * s + 5]); w0.w = pk2(s0[8 * s + 6], s0[8 * s + 7]);
            w1.x = pk2(s1[8 * s + 0], s1[8 * s + 1]); w1.y = pk2(s1[8 * s + 2], s1[8 * s + 3]); w1.z = pk2(s1[8 * s + 4], s1[8 * s + 5]); w1.w = pk2(s1[8 * s + 6], s1[8 * s + 7]);
            pkm[0][s] = __builtin_bit_cast(bf16x8, w0); pkm[1][s] = __builtin_bit_cast(bf16x8, w1);
        }
    }
}
template <int MODE>
DI void att_sm(f32x16 (&S)[2], bf16x8 (&pkm)[2][2], float& mrefm, float& lrunm, f32x16 (&om)[2], bool latent, const MaskP& mk, int h) {
    att_sm_head<MODE>(S, mrefm, lrunm, om, latent, mk, h);
    att_sm_tail(S, pkm, mrefm, lrunm);
}
DI void att_pvmm1(const s16x4 (&lo)[4], const s16x4 (&hi)[4], const bf16x8 (&pkm)[2][2], f32x16& oe) {
#pragma unroll
    for (int q = 0; q < 4; ++q) { const bf16x8 vf = (bf16x8){lo[q][0], lo[q][1], lo[q][2], lo[q][3], hi[q][0], hi[q][1], hi[q][2], hi[q][3]};
        oe = __builtin_amdgcn_mfma_f32_32x32x16_bf16(vf, pkm[q >> 1][q & 1], oe, 0, 0, 0); }
}
DI void att_vload(const LAS unsigned char* vb, int e, s16x4 (&lo)[4], s16x4 (&hi)[4]) {
    constexpr int VP = 144;
#pragma unroll
    for (int q = 0; q < 4; ++q) { const LAS unsigned char* p = vb + (16 * q) * VP + 64 * e;
        lo[q] = __builtin_bit_cast(s16x4, __builtin_amdgcn_ds_read_tr16_b64_v4i16((LAS s16x4*)p));
        hi[q] = __builtin_bit_cast(s16x4, __builtin_amdgcn_ds_read_tr16_b64_v4i16((LAS s16x4*)(p + 8 * VP))); }
}
template <int NMAP>
DI void att_pvmm(const s16x4 (&lo)[4], const s16x4 (&hi)[4], const bf16x8 (&pk)[NMAP][2][2], f32x16 (&o)[NMAP][2], int e) {
    __builtin_amdgcn_s_setprio(1);
#pragma unroll
    for (int q = 0; q < 4; ++q) { const bf16x8 vf = (bf16x8){lo[q][0], lo[q][1], lo[q][2], lo[q][3], hi[q][0], hi[q][1], hi[q][2], hi[q][3]};
#pragma unroll
        for (int mp = 0; mp < NMAP; ++mp) o[mp][e] = __builtin_amdgcn_mfma_f32_32x32x16_bf16(vf, pk[mp][q >> 1][q & 1], o[mp][e], 0, 0, 0); }
    __builtin_amdgcn_s_setprio(0);
}
template <int NMAP>
DI void att_pv(const LAS unsigned char* vb, const bf16x8 (&pk)[NMAP][2][2], f32x16 (&o)[NMAP][2]) {
#pragma unroll
    for (int e = 0; e < 2; ++e) {
        s16x4 lo[4], hi[4];
        __builtin_amdgcn_sched_barrier(0);
        att_vload(vb, e, lo, hi);
        __builtin_amdgcn_sched_barrier(0);
        att_pvmm<NMAP>(lo, hi, pk, o, e);
    }
    __builtin_amdgcn_sched_barrier(0);
}


template <int DQK, int NMAP, int MODE>
DI void attn_unit(LAS unsigned char* lds, const AttnU& a) {
    constexpr int DQM = DQK / NMAP, NKS = DQM / 16;
    constexpr int KP = DQK * 2 + 16, VP = 144, KBUF = 64 * KP, VBUF = 64 * VP, CPR = DQK / 8;
    constexpr int OFF_V = 2 * KBUF, OFF_RPB = 2 * KBUF + 3 * VBUF;
    const int tid = opaque_tid(), lane = tid & 63, r = lane & 31, h = lane >> 5, wid = __builtin_amdgcn_readfirstlane(tid >> 6);
    const int nt = 4 + (a.lt1 - a.lt0);
    const int kr0 = tid / CPR, kc0 = tid % CPR; const int c1 = tid + NTHR; const bool has1 = (64 * CPR > NTHR) && (c1 < 64 * CPR); const int kr1 = c1 / CPR, kc1 = c1 % CPR;
    const int vr = tid >> 3, vc = tid & 7;
    u32x4 kq0[3], kq1[3], vq[3];
#pragma unroll
    for (int q = 0; q < 3; ++q) { kq0[q] = (u32x4){0, 0, 0, 0}; kq1[q] = (u32x4){0, 0, 0, 0}; vq[q] = (u32x4){0, 0, 0, 0}; }
#define TILE_ROW(j) ((j) < 4 ? (MLAT + a.b * CTX + 64 * (j)) : (a.b * SEQ + 64 * (a.lt0 + (j) - 4)))
#define ATT_LOAD(Q, j) do { const int jj_ = ((j) < nt) ? (j) : nt - 1; const size_t rb_ = (size_t)TILE_ROW(jj_); kq0[Q] = *(const GAS u32x4*)(a.K + (rb_ + kr0) * a.ks + kc0 * 8); \
        if (has1) kq1[Q] = *(const GAS u32x4*)(a.K + (rb_ + kr1) * a.ks + kc1 * 8); vq[Q] = *(const GAS u32x4*)(a.V + (rb_ + vr) * a.vs + vc * 8); } while (0)
#define ATT_STORE(Q, kslot, vslot) do { *(LAS u32x4*)(lds + (kslot) * KBUF + kr0 * KP + kc0 * 16) = kq0[Q]; if (has1) *(LAS u32x4*)(lds + (kslot) * KBUF + kr1 * KP + kc1 * 16) = kq1[Q]; \
        *(LAS u32x4*)(lds + OFF_V + (vslot) * VBUF + vr * VP + vc * 16) = vq[Q]; } while (0)
    ATT_LOAD(0, 0); ATT_LOAD(1, 1); ATT_LOAD(2, 2);
    if (MODE == 1) { LAS float* rl = (LAS float*)(lds + OFF_RPB); for (int i = tid; i < 465; i += NTHR) rl[i] = ((const GAS float*)a.rpb)[i] * LOG2E; }
    bf16x8 qf[NMAP][NKS];
    { const bf16_t* qp = a.Q + (size_t)(32 * wid + r) * a.qs + 8 * h;
#pragma unroll
      for (int mp = 0; mp < NMAP; ++mp)
#pragma unroll
          for (int s = 0; s < NKS; ++s) qf[mp][s] = *(const GAS bf16x8*)(qp + mp * DQM + 16 * s); }
    float mref[NMAP], lrun[NMAP]; f32x16 o[NMAP][2];
#pragma unroll
    for (int mp = 0; mp < NMAP; ++mp) { mref[mp] = a.m0; lrun[mp] = (h == 0) ? a.l0 : 0.f;
#pragma unroll
        for (int e = 0; e < 2; ++e)
#pragma unroll
            for (int i = 0; i < 16; ++i) o[mp][e][i] = 0.f; }
    const int qw0 = a.q0 + 32 * wid;
    MaskP mk; mk.qrow = qw0 >> 6; mk.qcol = (qw0 & 63) + r; mk.qpos = qw0 + r; mk.rpbl = (const LAS float*)(lds + OFF_RPB); mk.lt = 0;
    { int rs = mk.qrow - 4; mk.rs = rs < 0 ? 0 : (rs > 120 ? 120 : rs); int cs = mk.qcol - 8; mk.cs = cs < 0 ? 0 : (cs > 48 ? 48 : cs); }
#define ATT_ACTIVE(j) ((j) < 4 ? true : (MODE == 1 ? ((a.lt0 + (j) - 4 >= mk.rs) && (a.lt0 + (j) - 4 < mk.rs + 8)) : (MODE == 2 ? ((64 * (a.lt0 + (j) - 4) + 63 >= qw0 - 128) && (64 * (a.lt0 + (j) - 4) <= qw0 + 31 + 128)) : true)))
    const LAS unsigned char* vlane = lds + OFF_V + (4 * h + ((lane & 15) >> 2)) * VP + ((lane >> 4) & 1) * 32 + (lane & 3) * 8;
    f32x16 S[2]; bf16x8 pk[NMAP][2][2];
    ATT_STORE(0, 0, 0);
    __syncthreads();
#define ATT_BODY_A(IT, P) { ATT_LOAD(P, (IT) + 3); \
        if ((IT) < nt && ATT_ACTIVE(IT)) { mk.lt = a.lt0 + (IT) - 4; \
            if (NMAP == 1) { s16x4 lo_[4], hi_[4]; \
                att_qk<DQK, NMAP>(lds + ((IT) & 1) * KBUF, r, h, qf[0], 0, S); __builtin_amdgcn_sched_barrier(0); \
                att_vload(vlane + (P) * VBUF, 0, lo_, hi_); __builtin_amdgcn_sched_barrier(0);       \
                att_sm<MODE>(S, pk[0], mref[0], lrun[0], o[0], (IT) >= 4, mk, h); __builtin_amdgcn_sched_barrier(0); \
                att_pvmm<NMAP>(lo_, hi_, pk, o, 0); __builtin_amdgcn_sched_barrier(0); \
                att_vload(vlane + (P) * VBUF, 1, lo_, hi_); __builtin_amdgcn_sched_barrier(0); \
                att_pvmm<NMAP>(lo_, hi_, pk, o, 1); __builtin_amdgcn_sched_barrier(0); \
            } else { s16x4 lo_[4], hi_[4]; \
                att_qk<DQK, NMAP>(lds + ((IT) & 1) * KBUF, r, h, qf[0], 0, S); __builtin_amdgcn_sched_barrier(0); \
                att_sm<MODE>(S, pk[0], mref[0], lrun[0], o[0], (IT) >= 4, mk, h); __builtin_amdgcn_sched_barrier(0); \
                att_qk<DQK, NMAP>(lds + ((IT) & 1) * KBUF, r, h, qf[NMAP - 1], NMAP - 1, S); __builtin_amdgcn_sched_barrier(0); \
                att_vload(vlane + (P) * VBUF, 0, lo_, hi_); __builtin_amdgcn_sched_barrier(0); \
                att_sm_head<MODE>(S, mref[NMAP - 1], lrun[NMAP - 1], o[NMAP - 1], (IT) >= 4, mk, h); __builtin_amdgcn_sched_barrier(0); \
                  \
                att_pvmm1(lo_, hi_, pk[0], o[0][0]); att_sm_tail(S, pk[NMAP - 1], mref[NMAP - 1], lrun[NMAP - 1]); \
                __builtin_amdgcn_sched_group_barrier(0x8, 1, 0); __builtin_amdgcn_sched_group_barrier(0x2, 20, 0); \
                __builtin_amdgcn_sched_group_barrier(0x8, 1, 0); __builtin_amdgcn_sched_group_barrier(0x2, 20, 0); \
                __builtin_amdgcn_sched_group_barrier(0x8, 1, 0); __builtin_amdgcn_sched_group_barrier(0x2, 20, 0); \
                __builtin_amdgcn_sched_group_barrier(0x8, 1, 0); __builtin_amdgcn_sched_group_barrier(0x2, 20, 0); \
                __builtin_amdgcn_sched_barrier(0); \
                att_pvmm1(lo_, hi_, pk[NMAP - 1], o[NMAP - 1][0]); __builtin_amdgcn_sched_barrier(0); \
                att_vload(vlane + (P) * VBUF, 1, lo_, hi_); __builtin_amdgcn_sched_barrier(0); \
                att_pvmm<NMAP>(lo_, hi_, pk, o, 1); __builtin_amdgcn_sched_barrier(0); } } \
        ATT_STORE(((P) + 1) % 3, ((IT) + 1) & 1, ((P) + 1) % 3); __syncthreads(); }
    __builtin_amdgcn_s_waitcnt(0x0F70);
    const int nt3 = ((nt + 2) / 3) * 3;
    for (int it = 0; it < nt3; it += 3) {
        ATT_BODY_A(it, 0);
        ATT_BODY_A(it + 1, 1);
        ATT_BODY_A(it + 2, 2);
    }
#undef ATT_BODY_A
#undef TILE_ROW
#undef ATT_LOAD
#undef ATT_STORE
#undef ATT_ACTIVE
    float inv[NMAP];
#pragma unroll
    for (int mp = 0; mp < NMAP; ++mp) { const float lt_ = lrun[mp] + __shfl_xor(lrun[mp], 32); inv[mp] = 1.0f / lt_; }
    f32x16 y[2];
    if (NMAP == 1) {
#pragma unroll
        for (int e = 0; e < 2; ++e)
#pragma unroll
            for (int i = 0; i < 16; ++i) y[e][i] = o[0][e][i] * inv[0];
    } else {
        float ss = 0.f; const float li = a.lam * inv[NMAP - 1];
#pragma unroll
        for (int e = 0; e < 2; ++e)
#pragma unroll
            for (int i = 0; i < 16; ++i) { const float v = o[0][e][i] * inv[0] - li * o[NMAP - 1][e][i]; y[e][i] = v; ss += v * v; }
        ss += __shfl_xor(ss, 32);
        const float rstd = rsqrtf(ss * (1.0f / 64.0f) + 1e-5f) * a.post;
#pragma unroll
        for (int e = 0; e < 2; ++e)
#pragma unroll
            for (int g4 = 0; g4 < 4; ++g4) { const f32x4 sg = *(const GAS f32x4*)(a.subln + 32 * e + 8 * g4 + 4 * h);
#pragma unroll
                for (int jj = 0; jj < 4; ++jj) y[e][4 * g4 + jj] *= rstd * sg[jj]; }
    }
    bf16_t* yp = a.Y + (size_t)(32 * wid + r) * a.ys + 8 * h;
#pragma unroll
    for (int e = 0; e < 2; ++e)
#pragma unroll
        for (int t = 0; t < 2; ++t) {
            const unsigned a0 = pk2(y[e][8 * t], y[e][8 * t + 1]), a1 = pk2(y[e][8 * t + 2], y[e][8 * t + 3]);
            const unsigned b0 = pk2(y[e][8 * t + 4], y[e][8 * t + 5]), b1 = pk2(y[e][8 * t + 6], y[e][8 * t + 7]);
            const auto r0 = __builtin_amdgcn_permlane32_swap(a0, b0, false, false), r1 = __builtin_amdgcn_permlane32_swap(a1, b1, false, false);
            u32x4 w; w.x = r0[0]; w.y = r1[0]; w.z = r0[1]; w.w = r1[1];
            *(GAS u32x4*)(yp + 32 * e + 16 * t) = w; }
}

struct Params { const float* in[27]; float* out; unsigned char* ws; };

struct ConvJob { const float* src; int K, N; bf16_t* dst; int ldd, koff, rowoff, mode; const float* kgain; int sn0, sn1; float scale; };
DI void conv_item(const ConvJob& J, LAS float* scr, int item, int lane) {
    const int nblk = J.N / 32, kb = item / nblk, nb = item % nblk, k0 = 64 * kb, n0 = 32 * nb;
    { float tv[32];
#pragma unroll
      for (int i = 0; i < 32; ++i) tv[i] = ((const GAS float*)J.src)[(size_t)(k0 + 2 * i + (lane >> 5)) * J.N + n0 + (lane & 31)];
#pragma unroll
      for (int i = 0; i < 32; ++i) scr[(2 * i + (lane >> 5)) * 33 + (lane & 31)] = tv[i]; }
    asm volatile("s_waitcnt lgkmcnt(0)" ::: "memory");
    const int c = lane & 7;
    float gk[8];
#pragma unroll
    for (int q = 0; q < 8; ++q) gk[q] = J.kgain ? J.kgain[k0 + 8 * c + q] : 1.0f;
#pragma unroll
    for (int j = 0; j < 4; ++j) { const int nl = (lane >> 3) + 8 * j, n = n0 + nl; const LAS float* s = scr + (8 * c) * 33 + nl;
        const float sc = (n >= J.sn0 && n < J.sn1) ? J.scale : 1.0f;
        int row = n;
        if (J.mode == 1) { const int hu = (n < DFF) ? n : n - DFF; row = 256 * (hu >> 7) + 64 * ((hu >> 5) & 3) + (hu & 31) + ((n < DFF) ? 0 : 32); }
        u32x4 o; o.x = pk2(s[0 * 33] * gk[0] * sc, s[1 * 33] * gk[1] * sc); o.y = pk2(s[2 * 33] * gk[2] * sc, s[3 * 33] * gk[3] * sc);
        o.z = pk2(s[4 * 33] * gk[4] * sc, s[5 * 33] * gk[5] * sc); o.w = pk2(s[6 * 33] * gk[6] * sc, s[7 * 33] * gk[7] * sc);
        *(u32x4*)(J.dst + (size_t)(J.rowoff + row) * J.ldd + J.koff + k0 + 8 * c) = o; }
    asm volatile("s_waitcnt lgkmcnt(0)" ::: "memory");
}

DI bool get_conv_job(LAS unsigned char* lds, int l, int j, ConvJob& J) {
    unsigned char* wl = WSP_ + WS_W + (size_t)l * WL;
    J.kgain = nullptr; J.sn0 = 0; J.sn1 = 0; J.scale = 1.f; J.koff = 0; J.rowoff = 0; J.mode = 0;
    switch (j) {
    case 0: J.src = INP_(7) + (size_t)l * DM * 2 * DFF; J.K = DM; J.N = 2 * DFF; J.dst = (bf16_t*)(wl + W_GU1); J.ldd = DM; J.mode = 1; return true;
    case 1: J.src = INP_(8) + (size_t)l * DFF * DM; J.K = DFF; J.N = DM; J.dst = (bf16_t*)(wl + W_DN1); J.ldd = DFF; return true;
    case 2: J.src = INP_(24) + (size_t)l * DM * 2 * DFF; J.K = DM; J.N = 2 * DFF; J.dst = (bf16_t*)(wl + W_GU2); J.ldd = DM; J.mode = 1; return true;
    case 3: J.src = INP_(25) + (size_t)l * DFF * DM; J.K = DFF; J.N = DM; J.dst = (bf16_t*)(wl + W_DN2); J.ldd = DFF; return true;
    case 4: J.src = INP_(10) + (size_t)l * DM * C_END; J.K = DM; J.N = C_END; J.dst = (bf16_t*)(wl + W_IN); J.ldd = DM; J.sn0 = C_NQ; J.sn1 = C_NK; J.scale = SC_C; return true;
    case 5: J.src = INP_(12) + (size_t)l * 256 * 384; J.K = 256; J.N = 384; J.dst = (bf16_t*)(wl + W_MLA); J.ldd = 384; J.kgain = INP_(11) + l * 256; return true;
    case 6: J.src = INP_(14) + (size_t)l * 128 * 512; J.K = 128; J.N = 512; J.dst = (bf16_t*)(wl + W_MLA); J.ldd = 384; J.koff = 256; J.rowoff = 384; J.kgain = INP_(13) + l * 128; return true;
    case 7: case 8: case 9: case 10: { const int i = j - 7; J.src = INP_(20) + ((size_t)l * 4 + i) * DM * DM; J.K = DM; J.N = DM; J.dst = (bf16_t*)(wl + W_GATE) + (size_t)i * DM * DM; J.ldd = DM; return true; }
    case 11: case 12: case 13: case 14: { const int i = j - 11; J.src = INP_(19) + ((size_t)l * 4 + i) * 256 * DM; J.K = 256; J.N = DM; J.dst = (bf16_t*)(wl + W_BR) + (size_t)i * DM * 256; J.ldd = 256; return true; }
    case 15: J.src = INP_(22) + (size_t)l * DM * DM; J.K = DM; J.N = DM; J.dst = (bf16_t*)(wl + W_OUT); J.ldd = DM; return true;
    default: return false;
    }
}

DI void prologue_phase(LAS unsigned char* lds, int G) {
    const int tid = opaque_tid(), lane = tid & 63, wave = tid >> 6, bid = opaque_bid();
    const int gw = bid * NWAVES + wave, NGW = G * NWAVES;
    LAS float* stab = (LAS float*)lds;
    unsigned char* const ws = WSP_; const float* const cin = INP_(1); const float* const ccin = INP_(3); const float* const wada = INP_(4); const float* const bada = INP_(5);
    for (int i = tid; i < 9 * DM; i += NTHR) { const float v = (i < 8 * DM) ? cin[i] : ccin[i - 8 * DM]; stab[i] = v * fast_rcp(1.0f + __expf(-v)); }
    __syncthreads();
    { float* MOD = (float*)(ws + WS_MOD); const int kq = lane >> 4, cc = lane & 15;
      for (int it = gw; it < 2 * 576; it += NGW) { const int l = it / 576, col = (it % 576) * 16 + cc;
          const float* w = wada + (size_t)l * DM * 9216 + col; float acc[9];
#pragma unroll
          for (int v = 0; v < 9; ++v) acc[v] = 0.f;
#pragma unroll 8
          for (int k = kq; k < DM; k += 4) { const float wv = w[(size_t)k * 9216];
#pragma unroll
              for (int v = 0; v < 9; ++v) acc[v] += stab[v * DM + k] * wv; }
#pragma unroll
          for (int v = 0; v < 9; ++v) { acc[v] += __shfl_xor(acc[v], 16); acc[v] += __shfl_xor(acc[v], 32); }
          if (kq == 0) { const float bb = bada[l * 9216 + col];
#pragma unroll
              for (int v = 0; v < 9; ++v) MOD[((size_t)l * 9 + v) * 9216 + col] = acc[v] + bb; } } }
    __syncthreads();
    { float* T32 = (float*)(ws + WS_TAB); float* T64 = T32 + 128 * 8 * 2; float* SCL = T64 + 128 * 16 * 2;
      const int gt = bid * NTHR + tid;
      if (gt < 128 * 8) { const int pos = gt >> 3, i = gt & 7; float t = (float)pos * (exp2f(-(float)i * (13.287712379549449f / 8.0f)) * 0.15915494309189535f); t -= rintf(t);
          T32[2 * gt] = __builtin_amdgcn_cosf(t); T32[2 * gt + 1] = __builtin_amdgcn_sinf(t); }
      else if (gt < 128 * 8 + 128 * 16) { const int g2 = gt - 128 * 8, pos = g2 >> 4, i = g2 & 15; float t = (float)pos * (exp2f(-(float)i * (13.287712379549449f / 16.0f)) * 0.15915494309189535f); t -= rintf(t);
          T64[2 * g2] = __builtin_amdgcn_cosf(t); T64[2 * g2 + 1] = __builtin_amdgcn_sinf(t); }
      else if (gt < 128 * 24 + 2) { const int l = gt - 128 * 24; const float* dl = INP_(15) + l * 128; float a0 = 0.f, a1 = 0.f;
          for (int i = 0; i < 32; ++i) { a0 += dl[i] * dl[32 + i]; a1 += dl[64 + i] * dl[96 + i]; }
          const float lam_init = 0.8f - 0.6f * __expf(-0.3f * (float)l);
          SCL[2 * l] = __expf(a0) - __expf(a1) + lam_init; SCL[2 * l + 1] = 1.0f - lam_init; } }
    for (int l = 0; l < 2; ++l) { unsigned char* wl = ws + WS_W + (size_t)l * WL;
        u32x4* zin = (u32x4*)(wl + W_IN + (size_t)C_END * DM * 2); const int nzin = (INP - C_END) * DM * 2 / 16;
        for (int i = bid * NTHR + tid; i < nzin; i += G * NTHR) zin[i] = (u32x4){0, 0, 0, 0};
        bf16_t* wm = (bf16_t*)(wl + W_MLA);
        for (int i = bid * NTHR + tid; i < 1024 * 384 / 8; i += G * NTHR) { const int row = i / 48, k8 = (i % 48) * 8;
            const bool z = (row < 384) ? (k8 >= 256) : (row < 896 ? (k8 < 256) : true);
            if (z) *(u32x4*)(wm + (size_t)row * 384 + k8) = (u32x4){0, 0, 0, 0}; } }
    { LAS float* scr = (LAS float*)(lds + wave * 16384); int rot = 0;
      for (int j = 0; j < 16; ++j) { ConvJob J; get_conv_job(lds, 0, j, J); const int nit = (J.K / 64) * (J.N / 32);
          int start = gw - rot; start %= NGW; if (start < 0) start += NGW;
          for (int it = start; it < nit; it += NGW) conv_item(J, scr, it, lane);
          rot = (rot + nit) % NGW; } }
}
DI void conv_tail_fill(LAS unsigned char* lds, int G) {
    const int tid = opaque_tid(), lane = tid & 63, wave = tid >> 6, bid = opaque_bid();
    const int nskip = (G > 64) ? 32 : 0;
    if (bid < nskip) return;
    const int gw = (bid - nskip) * NWAVES + wave, NGW = (G - nskip) * NWAVES;
    LAS float* scr = (LAS float*)(lds + wave * 16384); int rot = 0;
    for (int j = 0; j < 16; ++j) { ConvJob J; get_conv_job(lds, 1, j, J); const int nit = (J.K / 64) * (J.N / 32);
        int start = gw - rot; start %= NGW; if (start < 0) start += NGW;
        for (int it = start; it < nit; it += NGW) conv_item(J, scr, it, lane);
        rot = (rot + nit) % NGW; }
}

DI void nm_phase(const float* src_lat, const float* src_ctx, const float* gain, const float* modl, int ch_shift, int ch_scale, bf16_t* U, int M, int G, int row_lo = 0, int wg_lo = 0) {
    const int tid_ = opaque_tid(), lane = tid_ & 63, wave = tid_ >> 6, bid_ = opaque_bid();
    if (bid_ < wg_lo) return;
    const int gw = (bid_ - wg_lo) * NWAVES + wave, NGW = (G - wg_lo) * NWAVES;
    f32x4 gv[4];
#pragma unroll
    for (int j = 0; j < 4; ++j) gv[j] = *((const GAS f32x4*)gain + lane + 64 * j);
    for (int row0 = row_lo + gw; row0 < M; row0 += 2 * NGW) {
        const int row1 = row0 + NGW; const bool two = row1 < M;
        const float* xr0 = (row0 < MLAT) ? src_lat + (size_t)row0 * DM : src_ctx + (size_t)(row0 - MLAT) * DM;
        const float* xr1 = two ? ((row1 < MLAT) ? src_lat + (size_t)row1 * DM : src_ctx + (size_t)(row1 - MLAT) * DM) : xr0;
        f32x4 v0[4], v1[4]; float s0 = 0.f, s1 = 0.f;
#pragma unroll
        for (int j = 0; j < 4; ++j) { v0[j] = __builtin_nontemporal_load((const GAS f32x4*)xr0 + lane + 64 * j); v1[j] = __builtin_nontemporal_load((const GAS f32x4*)xr1 + lane + 64 * j); }
#pragma unroll
        for (int j = 0; j < 4; ++j) { s0 += (v0[j].x * v0[j].x + v0[j].y * v0[j].y) + (v0[j].z * v0[j].z + v0[j].w * v0[j].w); s1 += (v1[j].x * v1[j].x + v1[j].y * v1[j].y) + (v1[j].z * v1[j].z + v1[j].w * v1[j].w); }
        const float rstd0 = rsqrtf(wave_sum(s0) * (1.0f / DM) + 1e-6f), rstd1 = rsqrtf(wave_sum(s1) * (1.0f / DM) + 1e-6f);
        const int vec0 = (row0 < MLAT) ? (row0 >> 13) : 8, vec1 = two ? ((row1 < MLAT) ? (row1 >> 13) : 8) : vec0;
        const float* mv0 = modl + (size_t)vec0 * 9216; const float* mv1 = modl + (size_t)vec1 * 9216;
        f32x4 sh0[4], sc0[4], sh1[4], sc1[4];
#pragma unroll
        for (int j = 0; j < 4; ++j) { sh0[j] = *((const GAS f32x4*)(mv0 + ch_shift * 1024) + lane + 64 * j); sc0[j] = *((const GAS f32x4*)(mv0 + ch_scale * 1024) + lane + 64 * j);
            sh1[j] = *((const GAS f32x4*)(mv1 + ch_shift * 1024) + lane + 64 * j); sc1[j] = *((const GAS f32x4*)(mv1 + ch_scale * 1024) + lane + 64 * j); }
        { bf16_t* ur = U + (size_t)row0 * DM;
#pragma unroll
          for (int j = 0; j < 4; ++j) { const f32x4 o = v0[j] * rstd0 * gv[j] * (sc0[j] + 1.0f) + sh0[j]; u32x2 w; w.x = pk2(o.x, o.y); w.y = pk2(o.z, o.w); *((GAS u32x2*)ur + lane + 64 * j) = w; } }
        if (two) { bf16_t* ur = U + (size_t)row1 * DM;
#pragma unroll
          for (int j = 0; j < 4; ++j) { const f32x4 o = v1[j] * rstd1 * gv[j] * (sc1[j] + 1.0f) + sh1[j]; u32x2 w; w.x = pk2(o.x, o.y); w.y = pk2(o.z, o.w); *((GAS u32x2*)ur + lane + 64 * j) = w; } }
    }
}

DI void final_phase(float* H, const float* gain, int G) {
    const int tid_ = opaque_tid(), lane = tid_ & 63, wave = tid_ >> 6, gw = opaque_bid() * NWAVES + wave, NGW = G * NWAVES;
    f32x4 gv[4];
#pragma unroll
    for (int j = 0; j < 4; ++j) gv[j] = *((const GAS f32x4*)gain + lane + 64 * j);
    for (int row = gw; row < MLAT; row += NGW) { float* xr = H + (size_t)row * DM; f32x4 v[4]; float s = 0.f;
#pragma unroll
        for (int j = 0; j < 4; ++j) { v[j] = *((const GAS f32x4*)xr + lane + 64 * j); s += (v[j].x * v[j].x + v[j].y * v[j].y) + (v[j].z * v[j].z + v[j].w * v[j].w); }
        const float rstd = rsqrtf(wave_sum(s) * (1.0f / DM) + 1e-6f);
#pragma unroll
        for (int j = 0; j < 4; ++j) *((GAS f32x4*)xr + lane + 64 * j) = v[j] * rstd * gv[j]; }
}

DI void unpack8(const u32x4 w, float (&x)[8]) {
    x[0] = __uint_as_float(w.x << 16); x[1] = __uint_as_float(w.x & 0xffff0000u); x[2] = __uint_as_float(w.y << 16); x[3] = __uint_as_float(w.y & 0xffff0000u);
    x[4] = __uint_as_float(w.z << 16); x[5] = __uint_as_float(w.z & 0xffff0000u); x[6] = __uint_as_float(w.w << 16); x[7] = __uint_as_float(w.w & 0xffff0000u);
}
DI u32x4 pack8(const float (&x)[8]) { u32x4 w; w.x = pk2(x[0], x[1]); w.y = pk2(x[2], x[3]); w.z = pk2(x[4], x[5]); w.w = pk2(x[6], x[7]); return w; }
DI u32x4 rope_math(const u32x4 xw, const u32x4 pw, const f32x4 (&tb)[4], float sgn, float scale) {
    float x[8], xp[8], o[8]; unpack8(xw, x); unpack8(pw, xp);
#pragma unroll
    for (int q = 0; q < 4; ++q) { const f32x4 cs = tb[q];
        o[2 * q] = (x[2 * q] * cs[0] + sgn * xp[2 * q] * cs[1]) * scale; o[2 * q + 1] = (x[2 * q + 1] * cs[2] + sgn * xp[2 * q + 1] * cs[3]) * scale; }
    return pack8(o);
}
DI void derive_phase(LAS unsigned char* lds, int G) {
    const int tid_ = opaque_tid(), lane = tid_ & 63, wave = tid_ >> 6, gw = opaque_bid() * NWAVES + wave, NGW = G * NWAVES;
    unsigned char* const ws = WSP_;
    const GAS bf16_t* PB = (const GAS bf16_t*)(ws + WS_S + S_P); const GAS bf16_t* RB = (const GAS bf16_t*)(ws + WS_S + S_R);
    unsigned char* der = ws + WS_S + S_DER;
    GAS bf16_t *QA = (GAS bf16_t*)(der + D_QA), *KA = (GAS bf16_t*)(der + D_KA), *VA = (GAS bf16_t*)(der + D_VA), *QB = (GAS bf16_t*)(der + D_QB), *KB = (GAS bf16_t*)(der + D_KB), *QD = (GAS bf16_t*)(der + D_QD), *KD = (GAS bf16_t*)(der + D_KD);
    const GAS float* T32 = (const GAS float*)(ws + WS_TAB); const GAS float* T64 = T32 + 128 * 8 * 2;
    const int hh = (lane >> 3) & 3, cc = lane & 7;
    const bool q1 = lane < 32;
    const int c3 = lane & 31, e3 = (8 * c3) & 31;
    const bool q4 = (lane & 31) < 16; const int h4 = (lane >> 2) & 3, c4 = lane & 3, e4 = 8 * c4;
    const int c5 = q1 ? lane : lane - 32, e5 = (8 * c5) & 63;
    for (int row = gw; row < MALL; row += NGW) {
        const bool lat = row < MLAT; const int t = row & (SEQ - 1); const int prow = lat ? (t >> 6) : 0, pcol = lat ? (t & 63) : 0;
        const GAS bf16_t* p = PB + (size_t)row * INP; const GAS bf16_t* rr = RB + (size_t)row * DM;
        const u32x4 w0 = *(const GAS u32x4*)(p + (lane < 32 ? C_CQ + lane * 8 : C_CKV + ((lane - 32) & 15) * 8));
        const u32x4 a1 = *(const GAS u32x4*)(q1 ? rr + hh * 96 + cc * 8 : rr + 384 + hh * 128 + cc * 8);
        const u32x4 a2 = *(const GAS u32x4*)(rr + 384 + hh * 128 + 64 + cc * 8);
        const GAS bf16_t* b3 = p + (q1 ? C_DQ : C_DK);
        const u32x4 x3 = *(const GAS u32x4*)(b3 + 8 * c3), p3 = *(const GAS u32x4*)(b3 + 8 * (c3 ^ 1));
        const GAS bf16_t* b4 = q4 ? rr + h4 * 96 + 64 : p + C_KR;
        const u32x4 x4 = *(const GAS u32x4*)(b4 + 8 * c4), p4 = *(const GAS u32x4*)(b4 + 8 * (c4 ^ 1));
        const GAS bf16_t* b5 = p + (q1 ? C_GQ : C_GK);
        const u32x4 x5 = *(const GAS u32x4*)(b5 + 8 * c5), p5 = *(const GAS u32x4*)(b5 + 8 * (c5 ^ 2));
        f32x4 t3[4], t4[4], t5[4];
        { const GAS f32x4* a = (const GAS f32x4*)(T32 + (((e3 & 16) ? pcol : prow)) * 16); const GAS f32x4* b = (const GAS f32x4*)(T32 + (((e4 & 16) ? pcol : prow)) * 16);
          const GAS f32x4* c = (const GAS f32x4*)(T64 + ((((e5 & 32) ? pcol : prow)) * 16 + (e5 & 8)) * 2);
#pragma unroll
          for (int q = 0; q < 4; ++q) { t3[q] = a[q]; t4[q] = b[q]; t5[q] = c[q]; } }
        float sq = 0.f, skv = 0.f;
        { float x[8]; unpack8(w0, x); float a = 0.f;
#pragma unroll
          for (int q = 0; q < 8; ++q) a += x[q] * x[q];
          if (lane < 32) sq = a; else if (lane < 48) skv = a; }
        const float rq = rsqrtf(wave_sum(sq) * (1.0f / 256.0f) + 1e-6f), rkv = rsqrtf(wave_sum(skv) * (1.0f / 128.0f) + 1e-6f);
        { const float sc = q1 ? rq * SC_A : rkv; float x[8]; unpack8(a1, x);
#pragma unroll
          for (int q = 0; q < 8; ++q) x[q] *= sc;
          *(GAS u32x4*)((q1 ? QA : KA) + (size_t)row * 384 + hh * 96 + cc * 8) = pack8(x); }
        if (lane < 32) { float x[8]; unpack8(a2, x);
#pragma unroll
            for (int q = 0; q < 8; ++q) x[q] *= rkv;
            *(GAS u32x4*)(VA + (size_t)row * 256 + lane * 8) = pack8(x); }
        *(GAS u32x4*)((q1 ? QB : KB) + (size_t)row * 256 + 8 * c3) = rope_math(x3, p3, t3, (e3 & 8) ? 1.0f : -1.0f, q1 ? SC_B : 1.0f);
        if (lane < 32) *(GAS u32x4*)((q4 ? QA : KA) + (size_t)row * 384 + h4 * 96 + 64 + 8 * c4) = rope_math(x4, p4, t4, (e4 & 8) ? 1.0f : -1.0f, q4 ? rq * SC_A : 1.0f);
        if (lane < 48) { const u32x4 w = rope_math(x5, p5, t5, (e5 & 16) ? 1.0f : -1.0f, q1 ? SC_D : 1.0f);
            if (q1) *(GAS u32x4*)(QD + (size_t)row * 256 + 8 * c5) = w; else *(GAS u32x4*)(KD + (size_t)row * 128 + 8 * c5) = w; }
    }
}

DI void attn_phase(LAS unsigned char* lds, int l, int G) {
    unsigned char* const ws = WSP_;
    const bf16_t* PB = (const bf16_t*)(ws + WS_S + S_P);
    unsigned char* der = ws + WS_S + S_DER;
    const bf16_t *QA = (const bf16_t*)(der + D_QA), *KA = (const bf16_t*)(der + D_KA), *VA = (const bf16_t*)(der + D_VA), *QB = (const bf16_t*)(der + D_QB), *KB = (const bf16_t*)(der + D_KB),
                 *QD = (const bf16_t*)(der + D_QD), *KD = (const bf16_t*)(der + D_KD);
    bf16_t* Y = (bf16_t*)(ws + WS_S + S_Y);
    const float* SCL = (const float*)(ws + WS_TAB) + 128 * 24 * 2;
    const float lam = SCL[2 * l], post = SCL[2 * l + 1];
    const int bx = opaque_bid(); const int vc = (G % 8 == 0) ? ((bx % 8) * (G / 8) + bx / 8) : bx;
    const int nunits = 4096 + (l == 0 ? 128 : 0);
    for (int id = vc; id < nunits; id += G) {
        AttnU a; a.m0 = -1e30f; a.l0 = 0.f; a.rpb = nullptr; a.lam = lam; a.post = post; a.subln = INP_(16) + l * 64; a.ys = DM;
        int br, b, hh, qb; bool isctx = false;
        if (id < 4096) { br = id >> 10; const int rem = id & 1023; b = rem >> 7; hh = (rem >> 5) & 3; qb = rem & 31; }
        else { const int c = id - 4096; br = c >> 5; b = (c >> 2) & 7; hh = c & 3; qb = 0; isctx = true; }
        const size_t qrow = isctx ? (size_t)(MLAT + b * CTX) : (size_t)(b * SEQ + qb * 256);
        a.b = b; a.q0 = qb * 256; a.lt0 = 0; a.lt1 = isctx ? 0 : 128;
        a.Y = Y + qrow * DM + br * 256 + hh * 64;
        if (br == 0) { a.Q = QA + qrow * 384 + hh * 96; a.qs = 384; a.K = KA + hh * 96; a.ks = 384; a.V = VA + hh * 64; a.vs = 256;
            attn_unit<96, 1, 0>(lds, a); }
        else if (br == 1) { a.Q = QB + qrow * 256 + hh * 64; a.qs = 256; a.K = KB + hh * 64; a.ks = 256; a.V = PB + C_DV + hh * 64; a.vs = INP;
            attn_unit<64, 2, 0>(lds, a); }
        else if (br == 2) { a.Q = PB + qrow * INP + C_NQ + hh * 64; a.qs = INP; a.K = PB + C_NK + hh * 64; a.ks = INP; a.V = PB + C_NV + hh * 64; a.vs = INP;
            if (isctx) attn_unit<64, 1, 0>(lds, a);
            else { const int r0 = qb * 4; int lo = r0 - 4; lo = lo < 0 ? 0 : (lo > 120 ? 120 : lo); int hi = r0 + 3 - 4; hi = hi < 0 ? 0 : (hi > 120 ? 120 : hi);
                a.lt0 = lo; a.lt1 = hi + 8; a.rpb = INP_(17) + ((size_t)l * 4 + hh) * 465; attn_unit<64, 1, 1>(lds, a); } }
        else { a.Q = QD + qrow * 256 + hh * 64; a.qs = 256; a.K = KD + (hh >> 1) * 64; a.ks = 128; a.V = PB + C_GV + (hh >> 1) * 64; a.vs = INP;
            a.m0 = INP_(18)[l * 4 + hh] * LOG2E; a.l0 = 1.0f;
            if (!isctx) { int lo = a.q0 - 128; lo = lo < 0 ? 0 : lo; int hi = a.q0 + 256 + 128; hi = hi > SEQ ? SEQ : hi; a.lt0 = lo >> 6; a.lt1 = hi >> 6; }
            attn_unit<64, 1, 2>(lds, a); }
    }
}


constexpr size_t WS_BAR = WS_TAB + 512 * 1024;
#define XB_TMO      128
#define XB_XCNT(j)  (256  + 64 * (j))
#define XB_XSUB(j)  (1280 + 64 * (j))
#define XB_XGEN(j)  (2304 + 64 * (j))
#define XB_TOP      3328
#define XB_TOPGEN   3392
#define XCD_BAR_WORDS 3456
#define XB_SPIN_CAP (1u << 22)
DI unsigned xb_ld(unsigned* p)              { return __hip_atomic_load(p, __ATOMIC_RELAXED, __HIP_MEMORY_SCOPE_AGENT); }
DI unsigned xb_add(unsigned* p, unsigned v) { return __hip_atomic_fetch_add(p, v, __ATOMIC_RELAXED, __HIP_MEMORY_SCOPE_AGENT); }
DI unsigned xb_xcc_id() { return (unsigned)__builtin_amdgcn_s_getreg((3 << 11) | 20) & 0xFu; }
#define XB_SPIN(cond, bar) do { unsigned _sp = 0; while (cond) { __builtin_amdgcn_s_sleep(1); \
    if ((++_sp & 255u) == 0u) { if (xb_ld(&(bar)[XB_TMO])) break; if (_sp > XB_SPIN_CAP) { atomicAdd(&(bar)[XB_TMO], 1u); break; } } } } while (0)
struct XcdBarrier { unsigned* bar; unsigned x; volatile LAS unsigned* st; };
DI XcdBarrier xcd_barrier_post(unsigned* bar, volatile LAS unsigned* st) {
    XcdBarrier b; b.bar = bar; b.x = xb_xcc_id(); b.st = st;
    if (threadIdx.x == 0) (void)xb_add(&bar[XB_XCNT(b.x)], 1u);
    return b;
}
DI void xcd_barrier_complete(unsigned* bar, unsigned x, unsigned& nloc, unsigned& nx) {
    const unsigned G = gridDim.x * gridDim.y * gridDim.z;
    unsigned sum, cnt, mine, sp = 0u;
    for (;;) {
        sum = 0u; cnt = 0u; mine = 0u;
#pragma unroll
        for (unsigned j = 0; j < 16; ++j) { const unsigned c = xb_ld(&bar[XB_XCNT(j)]); sum += c; cnt += (c > 0u) ? 1u : 0u; mine = (j == x) ? c : mine; }
        if (sum == G) break;
        __builtin_amdgcn_s_sleep(1);
        if ((++sp & 255u) == 0u) { if (xb_ld(&bar[XB_TMO])) break; if (sp > XB_SPIN_CAP) { atomicAdd(&bar[XB_TMO], 1u); break; } }
    }
    nloc = mine > 0u ? mine : 1u; nx = cnt > 0u ? cnt : 1u;
}
DI void xcd_barrier(const XcdBarrier& b) {
    asm volatile("s_waitcnt vmcnt(0)" ::: "memory");
    __syncthreads();
    if (threadIdx.x == 0) {
        unsigned* bar = b.bar; asm volatile("" : "+s"(bar));
        unsigned bx_ = b.x; asm volatile("" : "+s"(bx_));
        __builtin_amdgcn_s_waitcnt(0);
        unsigned nloc = b.st[0], nx = b.st[1];
        if (nloc == 0u) { xcd_barrier_complete(bar, bx_, nloc, nx); b.st[0] = nloc; b.st[1] = nx; }
        const unsigned old = xb_add(&bar[XB_XSUB(bx_)], 1u);
        const unsigned gen = old / nloc;
        if (old + 1u == (gen + 1u) * nloc) {
            __builtin_amdgcn_fence(__ATOMIC_RELEASE, "agent");
            asm volatile("s_waitcnt vmcnt(0)" ::: "memory");
            const unsigned og = xb_add(&bar[XB_TOP], 1u);
            const unsigned tg = og / nx;
            if (og + 1u == (tg + 1u) * nx) xb_add(&bar[XB_TOPGEN], 1u);
            else XB_SPIN(xb_ld(&bar[XB_TOPGEN]) == tg, bar);
            __builtin_amdgcn_fence(__ATOMIC_ACQUIRE, "agent");
            xb_add(&bar[XB_XGEN(bx_)], 1u);
            asm volatile("s_waitcnt vmcnt(0)" ::: "memory");
        } else {
            XB_SPIN(xb_ld(&bar[XB_XGEN(bx_)]) == gen, bar);
            __builtin_amdgcn_fence(__ATOMIC_ACQUIRE, "agent");
            asm volatile("s_waitcnt vmcnt(0)" ::: "memory");
        }
    }
    __syncthreads();
}

constexpr int LDS_BYTES = 136 * 1024;
constexpr int STEPS_PER_LAYER = 20, NSTEPS = 2 * STEPS_PER_LAYER + 1;

__global__ void __launch_bounds__(NTHR, 2) mega_fwd(Params P) {
    extern __shared__ __attribute__((aligned(16))) unsigned char lds_raw[];
    LAS unsigned char* lds = (LAS unsigned char*)lds_raw;
    cg::grid_group grid = cg::this_grid();
    const int G = gridDim.x;
    {
        volatile LAS unsigned long long* tab = (volatile LAS unsigned long long*)(lds + CTLO); const int t = threadIdx.x;
#define TAB_(k) if (t == (k)) tab[k] = (unsigned long long)P.in[k];
        TAB_(0) TAB_(1) TAB_(2) TAB_(3) TAB_(4) TAB_(5) TAB_(6) TAB_(7) TAB_(8) TAB_(9) TAB_(10) TAB_(11) TAB_(12) TAB_(13) TAB_(14) TAB_(15) TAB_(16) TAB_(17) TAB_(18) TAB_(19)
        TAB_(20) TAB_(21) TAB_(22) TAB_(23) TAB_(24) TAB_(25) TAB_(26)
#undef TAB_
        if (t == 27) tab[27] = (unsigned long long)P.out;
        if (t == 28) tab[28] = (unsigned long long)P.ws;
        if (t == 29) { volatile LAS unsigned* st = (volatile LAS unsigned*)(lds + CTLO + 512); st[0] = 0u; st[1] = 0u; }
    }
    __syncthreads();
    const XcdBarrier xbar = xcd_barrier_post((unsigned*)(P.ws + WS_BAR), (volatile LAS unsigned*)(lds + CTLO + 512));

    prologue_phase(lds, G);
    grid.sync();

    bool skip_nm = false;
    for (int st = 0; st < NSTEPS; ++st) {
        unsigned char* const ws = WSP_;
        float* const H = OUTP_; float* const HC = (float*)(ws + WS_HC);
        bf16_t* const U = (bf16_t*)(ws + WS_U);
        bf16_t* const FFH = (bf16_t*)(ws + WS_S + S_FFH); bf16_t* const PBUF = (bf16_t*)(ws + WS_S + S_P); bf16_t* const RBUF = (bf16_t*)(ws + WS_S + S_R);
        bf16_t* const YB = (bf16_t*)(ws + WS_S + S_Y); bf16_t* const BRB = (bf16_t*)(ws + WS_S + S_BR); bf16_t* const MG = (bf16_t*)(ws + WS_S + S_MG);
        if (st == NSTEPS - 1) { final_phase(H, INP_(26), G); break; }
        const int l = st / STEPS_PER_LAYER, j = st % STEPS_PER_LAYER;
        const unsigned char* wl = ws + WS_W + (size_t)l * WL;
        const float* modl = (const float*)(ws + WS_MOD) + (size_t)l * 9 * 9216;
        const bool last = (l == 1);
        const int Mpost = last ? MLAT : MALL;
        bool is_gemm = false; pg8::Gemm g{}; pg8::Epi E{}; int M = MALL;
        const bool nm_skipped = skip_nm && (j == 0 || j == 3 || j == 17); if (nm_skipped) skip_nm = false;
        switch (nm_skipped ? 99 : j) {
        case 0: {
            const float* sl = (l == 0) ? INP_(0) : H; const float* sc = (l == 0) ? INP_(2) : HC;
            nm_phase(sl, sc, INP_(6) + l * DM, modl, 0, 1, U, MALL, G); break; }
        case 1: case 18: {
            is_gemm = true; M = (j == 1) ? MALL : Mpost; g = pg8::Gemm{U, (const bf16_t*)(wl + (j == 1 ? W_GU1 : W_GU2)), M, 2 * DFF, DM, DM};
            E.mode = 1; E.perm = true; E.O = FFH; E.ldc = DFF; break; }
        case 2: case 19: {
            is_gemm = true; M = (j == 2) ? MALL : Mpost; g = pg8::Gemm{FFH, (const bf16_t*)(wl + (j == 2 ? W_DN1 : W_DN2)), M, DM, DFF, DFF};
            E.mode = 2; E.perm = false; const bool first = (l == 0 && j == 2);
            E.base_lat = first ? INP_(0) : H; E.base_ctx = first ? INP_(2) : HC; E.out_lat = H; E.out_ctx = HC; E.modp = modl; E.gate_chunk = (j == 2) ? 2 : 8; E.gs = 0.5f; break; }
        case 3: nm_phase(H, HC, INP_(9) + l * DM, modl, 3, 4, U, MALL, G); break;
        case 4: { is_gemm = true; M = MALL; g = pg8::Gemm{U, (const bf16_t*)(wl + W_IN), M, INP, DM, DM}; E.mode = 0; E.perm = true; E.O = PBUF; E.ldc = INP; break; }
        case 5: { is_gemm = true; M = MALL; g = pg8::Gemm{PBUF, (const bf16_t*)(wl + W_MLA), M, 1024, 384, INP}; E.mode = 0; E.perm = true; E.O = RBUF; E.ldc = DM; break; }
        case 6: derive_phase(lds, G); break;
        case 7: attn_phase(lds, l, G); break;
        case 8: case 10: case 12: case 14: { const int i = (j - 8) >> 1;
            is_gemm = true; M = Mpost; g = pg8::Gemm{YB + 256 * i, (const bf16_t*)(wl + W_BR) + (size_t)i * DM * 256, M, DM, 256, DM}; E.mode = 0; E.perm = true; E.O = BRB; E.ldc = DM; break; }
        case 9: case 11: case 13: case 15: { const int i = (j - 9) >> 1;
            is_gemm = true; M = Mpost; g = pg8::Gemm{U, (const bf16_t*)(wl + W_GATE) + (size_t)i * DM * DM, M, DM, DM, DM};
            E.mode = 3; E.perm = true; E.bias = INP_(21) + ((size_t)l * 4 + i) * DM; E.BR = BRB; E.MG = MG; E.gi = i; break; }
        case 16: { is_gemm = true; M = Mpost; g = pg8::Gemm{BRB, (const bf16_t*)(wl + W_OUT), M, DM, DM, DM};
            E.mode = 2; E.perm = false; E.base_lat = H; E.base_ctx = HC; E.out_lat = H; E.out_ctx = HC; E.modp = modl; E.gate_chunk = 5; E.gs = 1.0f; break; }
        case 17: nm_phase(H, HC, INP_(23) + l * DM, modl, 6, 7, U, Mpost, G); break;
        default: break;
        }
        const bool split = is_gemm && E.mode == 2 && M == MALL && G > 64;
        const int nsub = split ? 2 : 1;
        const bool eperm = E.perm;
        if (is_gemm) {
            E.row_off = 0;
            if (threadIdx.x == 0) { pg8::epi_store(lds, E);
                volatile LAS unsigned long long* gq = (volatile LAS unsigned long long*)(lds + CTL_EPI + 128);
                gq[0] = (unsigned long long)g.A; gq[1] = (unsigned long long)g.Bt; gq[2] = ((unsigned long long)(unsigned)g.N << 32) | (unsigned)g.K; gq[3] = ((unsigned long long)(unsigned)M << 32) | (unsigned)g.lda; }
        }
        for (int sub = 0; sub < nsub; ++sub) {
            if (is_gemm) {
                if (split && sub == 1 && threadIdx.x == 0) ((volatile LAS pg8::EpiL*)(lds + CTL_EPI))->row_off = (unsigned)MLAT;
                __syncthreads();
                pg8::Gemm gs; { const unsigned long long nk = lds_u64(lds, CTL_EPI + 128 + 16), ml = lds_u64(lds, CTL_EPI + 128 + 24);
                    gs.A = (const bf16_t*)lds_u64(lds, CTL_EPI + 128); gs.Bt = (const bf16_t*)lds_u64(lds, CTL_EPI + 128 + 8); gs.N = (int)(nk >> 32); gs.K = (int)(unsigned)nk; gs.M = (int)(ml >> 32); gs.lda = (int)(unsigned)ml; }
                if (split) { if (sub == 0) gs.M = MLAT; else { gs.A = gs.A + (size_t)MLAT * gs.lda; gs.M = MCTX; } }
                pg8::StaticOrder S; S.init(gs.M, gs.N, G, (int)blockIdx.x); pg8::gemm_phase(lds, gs, S, eperm);
                if (l == 0 && j == 15) conv_tail_fill(lds, G); }
            if (split) {
                const float* ngain; const float* nmod; int nsh, nsc;
                if (j == 2) { ngain = INP_(9) + l * DM; nmod = modl; nsh = 3; nsc = 4; }
                else if (j == 16) { ngain = INP_(23) + l * DM; nmod = modl; nsh = 6; nsc = 7; }
                else { ngain = INP_(6) + (l + 1) * DM; nmod = modl + 9 * 9216; nsh = 0; nsc = 1; }
                if (sub == 0) xcd_barrier(xbar);
                else { nm_phase(H, HC, ngain, nmod, nsh, nsc, U, MLAT, G, 0, 32);
                       xcd_barrier(xbar);
                       nm_phase(H, HC, ngain, nmod, nsh, nsc, U, MALL, G, MLAT, 0);
                       skip_nm = true; }
            }
        }
        const bool nosync = (j >= 8 && j <= 14) || nm_skipped;
        if (!nosync) xcd_barrier(xbar);
    }
}

extern "C" void kernel_launch(void* const* d_in, const int* in_sizes, int n_in, void* d_out, int out_size, void* d_ws, size_t ws_size, hipStream_t stream) {
    static int grid_blocks = 0;
    if (grid_blocks == 0) {
        if (n_in != 27 || ws_size < WS_END) { fprintf(stderr, "kernel_launch: unexpected inputs (n_in %d, ws %zu < %zu)\n", n_in, ws_size, (size_t)WS_END); grid_blocks = -1; return; }
        int dev = 0, cus = 0, per_cu = 0;
        hipGetDevice(&dev);
        hipDeviceGetAttribute(&cus, hipDeviceAttributeMultiprocessorCount, dev);
        hipFuncSetAttribute((const void*)mega_fwd, hipFuncAttributeMaxDynamicSharedMemorySize, LDS_BYTES);
        hipOccupancyMaxActiveBlocksPerMultiprocessor(&per_cu, (const void*)mega_fwd, NTHR, LDS_BYTES);
        if (per_cu < 1) { fprintf(stderr, "kernel_launch: occupancy query returned %d\n", per_cu); per_cu = 1; }
        grid_blocks = cus * 1;
        (void)hipGetLastError();
    }
    if (grid_blocks < 0) return;
    Params p{};
    for (int i = 0; i < 27; ++i) p.in[i] = (const float*)d_in[i];
    p.out = (float*)d_out; p.ws = (unsigned char*)d_ws;
    (void)hipMemsetAsync((unsigned char*)d_ws + WS_BAR, 0, XCD_BAR_WORDS * 4, stream);
    void* args[] = {&p};
    hipError_t e = hipLaunchCooperativeKernel((const void*)mega_fwd, dim3(grid_blocks), dim3(NTHR), args, LDS_BYTES, stream);
    if (e != hipSuccess) fprintf(stderr, "cooperative launch failed: %s (grid %d)\n", hipGetErrorString(e), grid_blocks);
}
```

```cpp
#include <hip/hip_runtime.h>
#include <hip/hip_cooperative_groups.h>
#include <cstdint>
#include <cstdio>
namespace cg = cooperative_groups;

#define LAS __attribute__((address_space(3)))
#define DI __device__ __forceinline__
#define GAS __attribute__((address_space(1)))
typedef unsigned short bf16_t;
typedef short bf16x8 __attribute__((ext_vector_type(8)));
typedef short s16x4 __attribute__((ext_vector_type(4)));
typedef float f32x2 __attribute__((ext_vector_type(2)));
typedef float f32x4 __attribute__((ext_vector_type(4)));
typedef float f32x16 __attribute__((ext_vector_type(16)));
typedef unsigned u32x2 __attribute__((ext_vector_type(2)));
typedef unsigned u32x4 __attribute__((ext_vector_type(4)));
typedef __bf16 bf16x2_t __attribute__((ext_vector_type(2)));

constexpr int DM = 1024, NB = 8, SEQ = 8192, CTX = 256, DFF = 2816;
constexpr int MLAT = NB * SEQ, MCTX = NB * CTX, MALL = MLAT + MCTX;
constexpr int INP = 2560;
constexpr int NWAVES = 8, NTHR = 512;
constexpr float LOG2E = 1.4426950408889634f;
constexpr float SC_A = 0.10206207261596575f * LOG2E;
constexpr float SC_B = 0.17677669529663687f * LOG2E;
constexpr float SC_C = 0.125f * LOG2E;
constexpr float SC_D = 0.125f * LOG2E;
constexpr int C_CQ = 0, C_CKV = 256, C_KR = 384, C_DQ = 416, C_DK = 672, C_DV = 928, C_NQ = 1184, C_NK = 1440, C_NV = 1696, C_GQ = 1952, C_GK = 2208, C_GV = 2336, C_END = 2464;

constexpr size_t MiB = 1u << 20;
constexpr size_t WS_MOD = 0;
constexpr size_t WS_TAB = 1 * MiB;
constexpr size_t WS_W = 2 * MiB, WL = 51 * MiB;
constexpr size_t W_GU1 = 0, W_DN1 = 11 * MiB, W_GU2 = 16 * MiB + MiB / 2, W_DN2 = 27 * MiB + MiB / 2, W_IN = 33 * MiB, W_MLA = 38 * MiB,
                 W_GATE = 38 * MiB + 3 * MiB / 4, W_BR = 46 * MiB + 3 * MiB / 4, W_OUT = 48 * MiB + 3 * MiB / 4;
constexpr size_t WS_HC = 104 * MiB;
constexpr size_t WS_U = 112 * MiB;
constexpr size_t WS_S = 244 * MiB;
constexpr size_t S_P = 0, S_R = 330 * MiB, S_DER = 462 * MiB;
constexpr size_t S_FFH = 0, S_Y = S_R, S_BR = 0, S_MG = S_DER;
constexpr size_t D_QA = 0, D_KA = (size_t)MALL * 768, D_VA = D_KA + (size_t)MALL * 768, D_QB = D_VA + (size_t)MALL * 512, D_KB = D_QB + (size_t)MALL * 512,
                 D_QD = D_KB + (size_t)MALL * 512, D_KD = D_QD + (size_t)MALL * 512;
constexpr size_t WS_END = WS_S + 726 * MiB;

DI float bf2f(bf16_t u) { return __uint_as_float((unsigned)u << 16); }
DI unsigned f2bf(float f) { unsigned u = __float_as_uint(f); return (u + 0x7fffu + ((u >> 16) & 1u)) >> 16; }
DI unsigned pk2(float lo, float hi) { f32x2 v = {lo, hi}; bf16x2_t b = __builtin_convertvector(v, bf16x2_t); return __builtin_bit_cast(unsigned, b); }
DI float wave_sum(float v) {
#pragma unroll
    for (int o = 1; o < 64; o <<= 1) v += __shfl_xor(v, o);
    return v;
}
DI int opaque_tid() { int t = threadIdx.x; asm volatile("" : "+v"(t)); return t; }
DI int opaque_bid() { int t = blockIdx.x; asm volatile("" : "+s"(t)); return t; }
DI float fast_exp2(float x) { return __builtin_amdgcn_exp2f(x); }
DI float fast_rcp(float x) { return __builtin_amdgcn_rcpf(x); }


constexpr int CTLO = 131072, CTL_EPI = CTLO + 256;
DI unsigned long long lds_u64(LAS unsigned char* lds, int off) { const volatile LAS unsigned* p = (const volatile LAS unsigned*)(lds + off);
    const unsigned lo = __builtin_amdgcn_readfirstlane(p[0]), hi = __builtin_amdgcn_readfirstlane(p[1]); return ((unsigned long long)hi << 32) | lo; }
DI unsigned lds_u32(LAS unsigned char* lds, int off) { const volatile LAS unsigned* p = (const volatile LAS unsigned*)(lds + off); return __builtin_amdgcn_readfirstlane(p[0]); }
#define INP_(k) ((const float*)lds_u64(lds, CTLO + 8 * (k)))
#define OUTP_ ((float*)lds_u64(lds, CTLO + 8 * 27))
#define WSP_ ((unsigned char*)lds_u64(lds, CTLO + 8 * 28))

namespace pg8 {
constexpr int BM = 256, BK = 64, HALF = 128, HTB = HALF * BK * 2, STAGE_BYTES = 8 * HTB, NXCD = 8, WGM = 8;
DI int lds_byte(int r, int c) { const int st = (r >> 4) * 2 + (c >> 5), rr = r & 15, cc = c & 31, ob = rr * 64 + cc * 2; return st * 1024 + (ob ^ (((ob >> 9) & 1) << 5)); }
DI void stage_rc(int b, int& R, int& C) { const int st = b / 1024, sb = b % 1024, swz = sb ^ (((sb >> 9) & 1) << 5); R = (st >> 1) * 16 + swz / 64; C = (st & 1) * 32 + (swz % 64) / 2; }
DI int perm32(int rho) { const int n = rho >> 4, i = rho & 15; return 8 * (i >> 2) + 4 * n + (i & 3); }
struct Unit { int pm, pn; };
struct Gemm { const bf16_t* A; const bf16_t* Bt; int M, N, K, lda; };
struct StaticOrder {
    int nM, nN, nwg, G, c;
    DI void init(int M, int N, int G_, int c_) { nM = M / BM; nN = N / BM; nwg = nM * nN; G = G_; c = c_; }
    DI bool next(int i, Unit& u) const {
        const long L = (long)i * G + c; if (L >= nwg) return false;
        int wgid = (int)L; { const int q = nwg / NXCD, r = nwg % NXCD, xcd = wgid % NXCD, off = wgid / NXCD; wgid = (xcd < r ? xcd * (q + 1) : r * (q + 1) + (xcd - r) * q) + off; }
        const int nig = WGM * nN, gid = wgid / nig, fm = gid * WGM, gsz = (nM - fm) < WGM ? (nM - fm) : WGM;
        u.pm = fm + ((wgid % nig) % gsz); u.pn = (wgid % nig) / gsz; return true;
    }
};

struct Epi {
    int mode; bool perm;
    bf16_t* O; int ldc;
    const float* base_lat; const float* base_ctx; float* out_lat; float* out_ctx; const float* modp; int gate_chunk; float gs;
    const float* bias; bf16_t* BR; bf16_t* MG; int gi;
    int row_off;
    DI void operator()(const f32x4 (&acc)[2][2][4][2], const Unit& u, int wr, int wc, int fr, int fq) const {
        const int row0 = row_off + u.pm * BM + wr * 64 + fr;
        if (mode == 0) {
            const int col0 = u.pn * BM + wc * 64 + 8 * fq;
#pragma unroll
            for (int ai = 0; ai < 2; ++ai)
#pragma unroll
                for (int m = 0; m < 4; ++m) { bf16_t* rowp = O + (size_t)(row0 + ai * HALF + m * 16) * ldc + col0;
#pragma unroll
                    for (int bj = 0; bj < 2; ++bj) { const f32x4 v0 = acc[ai][bj][m][0], v1 = acc[ai][bj][m][1];
                        u32x4 w; w.x = pk2(v0[0], v0[1]); w.y = pk2(v0[2], v0[3]); w.z = pk2(v1[0], v1[1]); w.w = pk2(v1[2], v1[3]);
                        *(GAS u32x4*)(rowp + bj * 32) = w; } }
        } else if (mode == 1) {
            const int col0 = u.pn * (BM / 2) + wc * 32 + 8 * fq;
#pragma unroll
            for (int ai = 0; ai < 2; ++ai)
#pragma unroll
                for (int m = 0; m < 4; ++m) { bf16_t* rowp = O + (size_t)(row0 + ai * HALF + m * 16) * ldc + col0; float o[8];
#pragma unroll
                    for (int n = 0; n < 2; ++n) { const f32x4 g = acc[ai][0][m][n], up = acc[ai][1][m][n];
#pragma unroll
                        for (int j = 0; j < 4; ++j) o[4 * n + j] = g[j] * fast_rcp(1.0f + fast_exp2(-g[j] * LOG2E)) * up[j]; }
                    u32x4 w; w.x = pk2(o[0], o[1]); w.y = pk2(o[2], o[3]); w.z = pk2(o[4], o[5]); w.w = pk2(o[6], o[7]);
                    *(GAS u32x4*)rowp = w; }
        } else if (mode == 2) {
            const int rowt = row_off + u.pm * BM; const bool lat = rowt < MLAT;
            const int vec = lat ? (rowt >> 13) : 8;
            const float* bp = lat ? base_lat : base_ctx - (size_t)MLAT * DM; float* op = lat ? out_lat : out_ctx - (size_t)MLAT * DM;
            const float* mrow = modp + (size_t)vec * 9216 + gate_chunk * 1024;
            const int col0 = u.pn * BM + wc * 64 + 4 * fq;
            f32x4 gv[2][2];
#pragma unroll
            for (int bj = 0; bj < 2; ++bj)
#pragma unroll
                for (int n = 0; n < 2; ++n) gv[bj][n] = *(const GAS f32x4*)(mrow + col0 + bj * 32 + n * 16) * gs;
#pragma unroll
            for (int ai = 0; ai < 2; ++ai)
#pragma unroll
                for (int m = 0; m < 4; ++m) { const size_t off = (size_t)(row0 + ai * HALF + m * 16) * DM + col0; f32x4 b[2][2];
#pragma unroll
                    for (int bj = 0; bj < 2; ++bj)
#pragma unroll
                        for (int n = 0; n < 2; ++n) b[bj][n] = *(const GAS f32x4*)(bp + off + bj * 32 + n * 16);
#pragma unroll
                    for (int bj = 0; bj < 2; ++bj)
#pragma unroll
                        for (int n = 0; n < 2; ++n) *(GAS f32x4*)(op + off + bj * 32 + n * 16) = b[bj][n] + gv[bj][n] * acc[ai][bj][m][n]; }
        } else {
            const int col0 = u.pn * BM + wc * 64 + 8 * fq;
            f32x4 bb[2][2];
#pragma unroll
            for (int bj = 0; bj < 2; ++bj) { bb[bj][0] = *(const GAS f32x4*)(bias + col0 + bj * 32); bb[bj][1] = *(const GAS f32x4*)(bias + col0 + bj * 32 + 4); }
#pragma unroll
            for (int ai = 0; ai < 2; ++ai)
#pragma unroll
                for (int m = 0; m < 4; ++m) { const size_t offb = (size_t)(row0 + ai * HALF + m * 16) * DM + col0;
                    u32x4 brv[2], mgv[2];
#pragma unroll
                    for (int bj = 0; bj < 2; ++bj) { brv[bj] = *(const GAS u32x4*)(BR + offb + bj * 32); mgv[bj] = (gi > 0) ? *(const GAS u32x4*)(MG + offb + bj * 32) : (u32x4){0, 0, 0, 0}; }
#pragma unroll
                    for (int bj = 0; bj < 2; ++bj) { const size_t off = offb + bj * 32; const u32x4 br = brv[bj], mg = mgv[bj];
                        f32x4 x0 = acc[ai][bj][m][0] + bb[bj][0], x1 = acc[ai][bj][m][1] + bb[bj][1]; float v[8];
                        const float bv[8] = {__uint_as_float(br.x << 16), __uint_as_float(br.x & 0xffff0000u), __uint_as_float(br.y << 16), __uint_as_float(br.y & 0xffff0000u),
                                             __uint_as_float(br.z << 16), __uint_as_float(br.z & 0xffff0000u), __uint_as_float(br.w << 16), __uint_as_float(br.w & 0xffff0000u)};
#pragma unroll
                        for (int j = 0; j < 4; ++j) { v[j] = fast_rcp(1.0f + fast_exp2(-x0[j] * LOG2E)) * bv[j]; v[4 + j] = fast_rcp(1.0f + fast_exp2(-x1[j] * LOG2E)) * bv[4 + j]; }
                        v[0] += __uint_as_float(mg.x << 16); v[1] += __uint_as_float(mg.x & 0xffff0000u); v[2] += __uint_as_float(mg.y << 16); v[3] += __uint_as_float(mg.y & 0xffff0000u);
                        v[4] += __uint_as_float(mg.z << 16); v[5] += __uint_as_float(mg.z & 0xffff0000u); v[6] += __uint_as_float(mg.w << 16); v[7] += __uint_as_float(mg.w & 0xffff0000u);
                        u32x4 w; w.x = pk2(v[0], v[1]); w.y = pk2(v[2], v[3]); w.z = pk2(v[4], v[5]); w.w = pk2(v[6], v[7]);
                        if (gi < 3) *(GAS u32x4*)(MG + off) = w; else *(GAS u32x4*)(BR + off) = w; } }
        }
    }
};

struct EpiL { unsigned mode, perm, ldc, gate_chunk, gi; float gs; unsigned long long O, base_lat, base_ctx, out_lat, out_ctx, modp, bias, BR, MG; unsigned row_off, pad_; };
DI void epi_store(LAS unsigned char* lds, const Epi& e) {
    volatile LAS EpiL* p = (volatile LAS EpiL*)(lds + CTL_EPI);
    p->mode = e.mode; p->perm = e.perm ? 1u : 0u; p->ldc = e.ldc; p->gate_chunk = e.gate_chunk; p->gi = e.gi; p->gs = e.gs;
    p->O = (unsigned long long)e.O; p->base_lat = (unsigned long long)e.base_lat; p->base_ctx = (unsigned long long)e.base_ctx; p->out_lat = (unsigned long long)e.out_lat;
    p->out_ctx = (unsigned long long)e.out_ctx; p->modp = (unsigned long long)e.modp; p->bias = (unsigned long long)e.bias; p->BR = (unsigned long long)e.BR; p->MG = (unsigned long long)e.MG; p->row_off = (unsigned)e.row_off;
}
DI Epi epi_load(LAS unsigned char* lds) {
    const volatile LAS u32x4* p4 = (const volatile LAS u32x4*)(lds + CTL_EPI);
    u32x4 q[7];
#pragma unroll
    for (int i = 0; i < 7; ++i) q[i] = p4[i];
    unsigned w[28];
#pragma unroll
    for (int i = 0; i < 7; ++i) { w[4 * i] = __builtin_amdgcn_readfirstlane(q[i].x); w[4 * i + 1] = __builtin_amdgcn_readfirstlane(q[i].y); w[4 * i + 2] = __builtin_amdgcn_readfirstlane(q[i].z); w[4 * i + 3] = __builtin_amdgcn_readfirstlane(q[i].w); }
#define W64(k) (((unsigned long long)w[(k) + 1] << 32) | w[k])
    Epi e;
    e.mode = (int)w[0]; e.perm = w[1] != 0u; e.ldc = (int)w[2]; e.gate_chunk = (int)w[3]; e.gi = (int)w[4]; e.gs = __uint_as_float(w[5]);
    e.O = (bf16_t*)W64(6); e.base_lat = (const float*)W64(8); e.base_ctx = (const float*)W64(10); e.out_lat = (float*)W64(12); e.out_ctx = (float*)W64(14);
    e.modp = (const float*)W64(16); e.bias = (const float*)W64(18); e.BR = (bf16_t*)W64(20); e.MG = (bf16_t*)W64(22); e.row_off = (int)w[24];
#undef W64
    return e;
}

DI void gemm_phase(LAS unsigned char* lds, const Gemm g, const StaticOrder& S, const bool eperm) {
    const int tid = opaque_tid(), wid = __builtin_amdgcn_readfirstlane(tid >> 6), lane = tid & 63, wr = wid >> 2, wc = wid & 3, fr = lane & 15, fq = lane >> 4;
    const int K = g.K, nt = K / BK, lda = g.lda;
    unsigned voffA[2], voffB[2];
#pragma unroll
    for (int i = 0; i < 2; ++i) { int R, C; stage_rc(tid * 16 + i * 8192, R, C); const int Rb = 64 * (R >> 5) + (eperm ? perm32(R & 31) : (R & 31));
        voffA[i] = (unsigned)(R * lda + C) * 2u; voffB[i] = (unsigned)(Rb * K + C) * 2u; }
    const size_t kstep = (size_t)(BK * 2);
    const size_t hstepA = (size_t)HALF * lda * 2, tstepA = 2 * hstepA, hstepB = (size_t)32 * K * 2, tstepB = (size_t)BM * K * 2;
    const unsigned ldsw = (unsigned)wid * 1024u;
    const int aoff = lds_byte(wr * 64 + fr, fq * 8), boff = lds_byte(wc * 32 + fr, fq * 8);
#define PG8_SA(b, h) (((b) * 2 + (h)) * HTB)
#define PG8_SB(b, h) ((4 + (b) * 2 + (h)) * HTB)
#define PG8_STAGE(bufoff, gbase, voff) do { _Pragma("unroll") for (int _i = 0; _i < 2; ++_i) \
        __builtin_amdgcn_global_load_lds((const unsigned*)((const char*)(gbase) + (voff)[_i]), (LAS unsigned*)(lds + (bufoff) + ldsw + _i * 8192), 16, 0, 0); } while (0)
#define PG8_LDA(dst, b, h) do { _Pragma("unroll") for (int m = 0; m < 4; ++m) _Pragma("unroll") for (int k = 0; k < 2; ++k) dst[m][k] = *(const LAS bf16x8*)(lds + PG8_SA(b, h) + aoff + m * 2048 + k * 1024); } while (0)
#define PG8_LDB(dst, b, h) do { _Pragma("unroll") for (int n = 0; n < 2; ++n) _Pragma("unroll") for (int k = 0; k < 2; ++k) dst[n][k] = *(const LAS bf16x8*)(lds + PG8_SB(b, h) + boff + n * 2048 + k * 1024); } while (0)
#define PG8_MMA(ai, bj, At, Bt) do { __builtin_amdgcn_s_setprio(1); _Pragma("unroll") for (int m = 0; m < 4; ++m) _Pragma("unroll") for (int n = 0; n < 2; ++n) _Pragma("unroll") for (int k = 0; k < 2; ++k) \
        acc[ai][bj][m][n] = __builtin_amdgcn_mfma_f32_16x16x32_bf16(Bt[n][k], At[m][k], acc[ai][bj][m][n], 0, 0, 0); __builtin_amdgcn_s_setprio(0); } while (0)
#define PG8_WAIT_V(n) asm volatile("s_waitcnt vmcnt(" #n ")" ::: "memory")
#define PG8_WAIT_L(n) asm volatile("s_waitcnt lgkmcnt(" #n ")" ::: "memory")
#define PG8_BAR __builtin_amdgcn_s_barrier()
#define PG8_SCHED __builtin_amdgcn_sched_barrier(0)
    Unit cur, nxt; int ui = 0;
    if (!S.next(0, cur)) return;
    f32x4 acc[2][2][4][2];
#pragma unroll
    for (int a = 0; a < 2; ++a)
#pragma unroll
        for (int b = 0; b < 2; ++b)
#pragma unroll
            for (int m = 0; m < 4; ++m)
#pragma unroll
                for (int n = 0; n < 2; ++n) acc[a][b][m][n] = (f32x4){0.f, 0.f, 0.f, 0.f};
    bf16x8 At[4][2], B0[2][2], B1[2][2];
    const char* cA = (const char*)g.A + (size_t)cur.pm * tstepA; const char* cB = (const char*)g.Bt + (size_t)cur.pn * tstepB;
    PG8_STAGE(PG8_SB(0, 0), cB, voffB); PG8_STAGE(PG8_SB(0, 1), cB + hstepB, voffB); PG8_STAGE(PG8_SA(0, 0), cA, voffA); PG8_STAGE(PG8_SA(0, 1), cA + hstepA, voffA);
    if (wr == 1) PG8_BAR;
    PG8_WAIT_V(2); PG8_BAR;
    PG8_STAGE(PG8_SB(1, 0), cB + kstep, voffB); PG8_STAGE(PG8_SA(1, 0), cA + kstep, voffA); PG8_STAGE(PG8_SB(1, 1), cB + hstepB + kstep, voffB);
    PG8_WAIT_V(6); PG8_BAR;
    for (;;) {
        const bool has_next = S.next(ui + 1, nxt);
        const char* nA = has_next ? (const char*)g.A + (size_t)nxt.pm * tstepA : cA; const char* nB = has_next ? (const char*)g.Bt + (size_t)nxt.pn * tstepB : cB;
        for (int t = 0; t < nt; t += 2) {
            const bool last = (t == nt - 2);
            const char* a1 = cA + (size_t)(t + 1) * kstep;
            const char* a2 = last ? nA : cA + (size_t)(t + 2) * kstep; const char* b2 = last ? nB : cB + (size_t)(t + 2) * kstep;
            const char* a3 = a2 + kstep; const char* b3 = b2 + kstep;
            PG8_LDB(B0, 0, 0); PG8_LDB(B1, 0, 1); PG8_SCHED; PG8_LDA(At, 0, 0); PG8_STAGE(PG8_SA(1, 1), a1 + hstepA, voffA);
            PG8_WAIT_V(8); PG8_WAIT_L(0); PG8_BAR; PG8_MMA(0, 0, At, B0); PG8_MMA(0, 1, At, B1); PG8_BAR; PG8_SCHED;
            PG8_LDA(At, 0, 1); PG8_STAGE(PG8_SB(0, 0), b2, voffB); PG8_STAGE(PG8_SB(0, 1), b2 + hstepB, voffB); PG8_STAGE(PG8_SA(0, 0), a2, voffA);
            PG8_WAIT_V(8); PG8_WAIT_L(0); PG8_BAR; PG8_MMA(1, 0, At, B0); PG8_MMA(1, 1, At, B1); PG8_BAR; PG8_SCHED;
            PG8_LDB(B0, 1, 0); PG8_LDB(B1, 1, 1); PG8_SCHED; PG8_LDA(At, 1, 0); PG8_STAGE(PG8_SA(0, 1), a2 + hstepA, voffA);
            PG8_WAIT_V(8); PG8_WAIT_L(0); PG8_BAR; PG8_MMA(0, 0, At, B0); PG8_MMA(0, 1, At, B1); PG8_BAR; PG8_SCHED;
            PG8_LDA(At, 1, 1); PG8_STAGE(PG8_SB(1, 0), b3, voffB); PG8_STAGE(PG8_SB(1, 1), b3 + hstepB, voffB); PG8_STAGE(PG8_SA(1, 0), a3, voffA);
            PG8_WAIT_V(8); PG8_WAIT_L(0); PG8_BAR; PG8_MMA(1, 0, At, B0); PG8_MMA(1, 1, At, B1); PG8_BAR; PG8_SCHED;
        }
        if (wr == 0) PG8_BAR;
        { const Epi E = epi_load(lds); E(acc, cur, wr, wc, fr, fq); }
        if (!has_next) break;
#pragma unroll
        for (int a = 0; a < 2; ++a)
#pragma unroll
            for (int b = 0; b < 2; ++b)
#pragma unroll
                for (int m = 0; m < 4; ++m)
#pragma unroll
                    for (int n = 0; n < 2; ++n) acc[a][b][m][n] = (f32x4){0.f, 0.f, 0.f, 0.f};
        cur = nxt; cA = nA; cB = nB; ++ui;
        if (wr == 1) PG8_BAR;
    }
    PG8_WAIT_V(0);
    PG8_BAR;
#undef PG8_SA
#undef PG8_SB
#undef PG8_STAGE
#undef PG8_LDA
#undef PG8_LDB
#undef PG8_MMA
#undef PG8_WAIT_V
#undef PG8_WAIT_L
#undef PG8_BAR
#undef PG8_SCHED
}
}

struct AttnU {
    const bf16_t* Q; const bf16_t* K; const bf16_t* V; bf16_t* Y;
    int qs, ks, vs, ys;
    int b, lt0, lt1;
    int q0;
    float m0, l0;
    const float* rpb;
    float lam, post; const float* subln;
};
DI int crow(int i, int h) { return (i & 3) + 8 * (i >> 2) + 4 * h; }

template <int DQK, int NMAP>
DI void att_qk(const LAS unsigned char* Kb, int r, int h, const bf16x8 (&qfm)[DQK / NMAP / 16], int mp, f32x16 (&S)[2]) {
    constexpr int DQM = DQK / NMAP, NKS = DQM / 16, KP = DQK * 2 + 16, CH = (NKS > 4) ? 3 : NKS;
    const LAS unsigned char* kp = Kb + r * KP + (mp * DQM + 8 * h) * 2;
    const f32x16 z = {0.f, 0.f, 0.f, 0.f, 0.f, 0.f, 0.f, 0.f, 0.f, 0.f, 0.f, 0.f, 0.f, 0.f, 0.f, 0.f};
#pragma unroll
    for (int c = 0; c < NKS / CH; ++c) {
        bf16x8 kf[2 * CH];
#pragma unroll
        for (int s = 0; s < CH; ++s) { kf[2 * s] = *(const LAS bf16x8*)(kp + 32 * (c * CH + s)); kf[2 * s + 1] = *(const LAS bf16x8*)(kp + 32 * KP + 32 * (c * CH + s)); }
        __builtin_amdgcn_sched_barrier(0);
        __builtin_amdgcn_s_setprio(1);
#pragma unroll
        for (int s = 0; s < CH; ++s) {
            if (c == 0 && s == 0) { S[0] = __builtin_amdgcn_mfma_f32_32x32x16_bf16(kf[0], qfm[0], z, 0, 0, 0); S[1] = __builtin_amdgcn_mfma_f32_32x32x16_bf16(kf[1], qfm[0], z, 0, 0, 0); }
            else { S[0] = __builtin_amdgcn_mfma_f32_32x32x16_bf16(kf[2 * s], qfm[c * CH + s], S[0], 0, 0, 0); S[1] = __builtin_amdgcn_mfma_f32_32x32x16_bf16(kf[2 * s + 1], qfm[c * CH + s], S[1], 0, 0, 0); }
        }
        __builtin_amdgcn_s_setprio(0);
        __builtin_amdgcn_sched_barrier(0);
    }
}
struct MaskP { int lt, qrow, qcol, rs, cs, qpos; const LAS float* rpbl; };
template <int MODE>
DI void att_sm_head(f32x16 (&S)[2], float& mrefm, float& lrunm, f32x16 (&om)[2], bool latent, const MaskP& mk, int h) {
    {
        f32x16& s0 = S[0]; f32x16& s1 = S[1];
        if (MODE == 1 && latent) {
            const LAS float* rl = mk.rpbl + (mk.lt - mk.qrow + 7) * 31 + (15 - mk.qcol);
#pragma unroll
            for (int i = 0; i < 16; ++i) { const int kc = crow(i, h);
                { const bool ok = (kc >= mk.cs) && (kc < mk.cs + 16); const float bz = rl[ok ? kc : mk.qcol]; s0[i] = ok ? s0[i] + bz : -1e30f; }
                { const int kc2 = kc + 32; const bool ok = (kc2 >= mk.cs) && (kc2 < mk.cs + 16); const float bz = rl[ok ? kc2 : mk.qcol]; s1[i] = ok ? s1[i] + bz : -1e30f; } }
        }
        if (MODE == 2 && latent) {
            const int kb = 64 * mk.lt;
#pragma unroll
            for (int i = 0; i < 16; ++i) { const int d0 = kb + crow(i, h) - mk.qpos, d1 = d0 + 32;
                if (d0 > 128 || d0 < -128) s0[i] = -1e30f; if (d1 > 128 || d1 < -128) s1[i] = -1e30f; }
        }
        float ma = fmaxf(fmaxf(s0[0], s0[1]), s0[2]), mb = fmaxf(fmaxf(s1[0], s1[1]), s1[2]);
#pragma unroll
        for (int i = 3; i < 15; i += 2) { ma = fmaxf(fmaxf(ma, s0[i]), s0[i + 1]); mb = fmaxf(fmaxf(mb, s1[i]), s1[i + 1]); }
        ma = fmaxf(fmaxf(ma, s0[15]), fmaxf(mb, s1[15]));
        { auto rr = __builtin_amdgcn_permlane32_swap(__float_as_uint(ma), __float_as_uint(ma), false, false); ma = fmaxf(__uint_as_float(rr[0]), __uint_as_float(rr[1])); }
        const bool uninit = mrefm < -1e29f;
        const bool need = uninit || (ma - mrefm > 8.0f);
        if (__any(need)) {
            const float mnew = need ? ma : mrefm;
            const float f = uninit ? 1.0f : fast_exp2(mrefm - mnew);
            mrefm = mnew; lrunm *= f;
#pragma unroll
            for (int e = 0; e < 2; ++e)
#pragma unroll
                for (int i = 0; i < 16; ++i) om[e][i] *= f;
        }
    }
}
DI void att_sm_tail(f32x16 (&S)[2], bf16x8 (&pkm)[2][2], const float mrefm, float& lrunm) {
    {
        f32x16& s0 = S[0]; f32x16& s1 = S[1];
        const f32x2 nm2 = {-mrefm, -mrefm};
        f32x2 acc2 = {0.f, 0.f};
#pragma unroll
        for (int i = 0; i < 16; i += 2) {
            f32x2 a = {s0[i], s0[i + 1]}, b = {s1[i], s1[i + 1]}; a += nm2; b += nm2;
            a.x = fast_exp2(a.x); a.y = fast_exp2(a.y); b.x = fast_exp2(b.x); b.y = fast_exp2(b.y);
            acc2 += a; acc2 += b; s0[i] = a.x; s0[i + 1] = a.y; s1[i] = b.x; s1[i + 1] = b.y;
        }
        lrunm += acc2.x + acc2.y;
#pragma unroll
        for (int s = 0; s < 2; ++s) {
            u32x4 w0, w1;
            w0.x = pk2(s0[8 * s + 0], s0[8 * s + 1]); w0.y = pk2(s0[8 * s + 2], s0[8 * s + 3]); w0.z = pk2(s0[8 * s + 4], s0[8 * s + 5]); w0.w = pk2(s0[8 * s + 6], s0[8 * s + 7]);
            w1.x = pk2(s1[8 * s + 0], s1[8 * s + 1]); w1.y = pk2(s1[8 * s + 2], s1[8 * s + 3]); w1.z = pk2(s1[8 * s + 4], s1[8 * s + 5]); w1.w = pk2(s1[8 * s + 6], s1[8 * s + 7]);
            pkm[0][s] = __builtin_bit_cast(bf16x8, w0); pkm[1][s] = __builtin_bit_cast(bf16x8, w1);
        }
    }
}
template <int MODE>
DI void att_sm(f32x16 (&S)[2], bf16x8 (&pkm)[2][2], float& mrefm, float& lrunm, f32x16 (&om)[2], bool latent, const MaskP& mk, int h) {
    att_sm_head<MODE>(S, mrefm, lrunm, om, latent, mk, h);
    att_sm_tail(S, pkm, mrefm, lrunm);
}
DI void att_pvmm1(const s16x4 (&lo)[4], const s16x4 (&hi)[4], const bf16x8 (&pkm)[2][2], f32x16& oe) {
#pragma unroll
    for (int q = 0; q < 4; ++q) { const bf16x8 vf = (bf16x8){lo[q][0], lo[q][1], lo[q][2], lo[q][3], hi[q][0], hi[q][1], hi[q][2], hi[q][3]};
        oe = __builtin_amdgcn_mfma_f32_32x32x16_bf16(vf, pkm[q >> 1][q & 1], oe, 0, 0, 0); }
}
DI void att_vload(const LAS unsigned char* vb, int e, s16x4 (&lo)[4], s16x4 (&hi)[4]) {
    constexpr int VP = 144;
#pragma unroll
    for (int q = 0; q < 4; ++q) { const LAS unsigned char* p = vb + (16 * q) * VP + 64 * e;
        lo[q] = __builtin_bit_cast(s16x4, __builtin_amdgcn_ds_read_tr16_b64_v4i16((LAS s16x4*)p));
        hi[q] = __builtin_bit_cast(s16x4, __builtin_amdgcn_ds_read_tr16_b64_v4i16((LAS s16x4*)(p + 8 * VP))); }
}
template <int NMAP>
DI void att_pvmm(const s16x4 (&lo)[4], const s16x4 (&hi)[4], const bf16x8 (&pk)[NMAP][2][2], f32x16 (&o)[NMAP][2], int e) {
    __builtin_amdgcn_s_setprio(1);
#pragma unroll
    for (int q = 0; q < 4; ++q) { const bf16x8 vf = (bf16x8){lo[q][0], lo[q][1], lo[q][2], lo[q][3], hi[q][0], hi[q][1], hi[q][2], hi[q][3]};
#pragma unroll
        for (int mp = 0; mp < NMAP; ++mp) o[mp][e] = __builtin_amdgcn_mfma_f32_32x32x16_bf16(vf, pk[mp][q >> 1][q & 1], o[mp][e], 0, 0, 0); }
    __builtin_amdgcn_s_setprio(0);
}
template <int NMAP>
DI void att_pv(const LAS unsigned char* vb, const bf16x8 (&pk)[NMAP][2][2], f32x16 (&o)[NMAP][2]) {
#pragma unroll
    for (int e = 0; e < 2; ++e) {
        s16x4 lo[4], hi[4];
        __builtin_amdgcn_sched_barrier(0);
        att_vload(vb, e, lo, hi);
        __builtin_amdgcn_sched_barrier(0);
        att_pvmm<NMAP>(lo, hi, pk, o, e);
    }
    __builtin_amdgcn_sched_barrier(0);
}


template <int DQK, int NMAP, int MODE>
DI void attn_unit(LAS unsigned char* lds, const AttnU& a) {
    constexpr int DQM = DQK / NMAP, NKS = DQM / 16;
    constexpr int KP = DQK * 2 + 16, VP = 144, KBUF = 64 * KP, VBUF = 64 * VP, CPR = DQK / 8;
    constexpr int OFF_V = 2 * KBUF, OFF_RPB = 2 * KBUF + 3 * VBUF;
    const int tid = opaque_tid(), lane = tid & 63, r = lane & 31, h = lane >> 5, wid = __builtin_amdgcn_readfirstlane(tid >> 6);
    const int nt = 4 + (a.lt1 - a.lt0);
    const int kr0 = tid / CPR, kc0 = tid % CPR; const int c1 = tid + NTHR; const bool has1 = (64 * CPR > NTHR) && (c1 < 64 * CPR); const int kr1 = c1 / CPR, kc1 = c1 % CPR;
    const int vr = tid >> 3, vc = tid & 7;
    u32x4 kq0[3], kq1[3], vq[3];
#pragma unroll
    for (int q = 0; q < 3; ++q) { kq0[q] = (u32x4){0, 0, 0, 0}; kq1[q] = (u32x4){0, 0, 0, 0}; vq[q] = (u32x4){0, 0, 0, 0}; }
#define TILE_ROW(j) ((j) < 4 ? (MLAT + a.b * CTX + 64 * (j)) : (a.b * SEQ + 64 * (a.lt0 + (j) - 4)))
#define ATT_LOAD(Q, j) do { const int jj_ = ((j) < nt) ? (j) : nt - 1; const size_t rb_ = (size_t)TILE_ROW(jj_); kq0[Q] = *(const GAS u32x4*)(a.K + (rb_ + kr0) * a.ks + kc0 * 8); \
        if (has1) kq1[Q] = *(const GAS u32x4*)(a.K + (rb_ + kr1) * a.ks + kc1 * 8); vq[Q] = *(const GAS u32x4*)(a.V + (rb_ + vr) * a.vs + vc * 8); } while (0)
#define ATT_STORE(Q, kslot, vslot) do { *(LAS u32x4*)(lds + (kslot) * KBUF + kr0 * KP + kc0 * 16) = kq0[Q]; if (has1) *(LAS u32x4*)(lds + (kslot) * KBUF + kr1 * KP + kc1 * 16) = kq1[Q]; \
        *(LAS u32x4*)(lds + OFF_V + (vslot) * VBUF + vr * VP + vc * 16) = vq[Q]; } while (0)
    ATT_LOAD(0, 0); ATT_LOAD(1, 1); ATT_LOAD(2, 2);
    if (MODE == 1) { LAS float* rl = (LAS float*)(lds + OFF_RPB); for (int i = tid; i < 465; i += NTHR) rl[i] = ((const GAS float*)a.rpb)[i] * LOG2E; }
    bf16x8 qf[NMAP][NKS];
    { const bf16_t* qp = a.Q + (size_t)(32 * wid + r) * a.qs + 8 * h;
#pragma unroll
      for (int mp = 0; mp < NMAP; ++mp)
#pragma unroll
          for (int s = 0; s < NKS; ++s) qf[mp][s] = *(const GAS bf16x8*)(qp + mp * DQM + 16 * s); }
    float mref[NMAP], lrun[NMAP]; f32x16 o[NMAP][2];
#pragma unroll
    for (int mp = 0; mp < NMAP; ++mp) { mref[mp] = a.m0; lrun[mp] = (h == 0) ? a.l0 : 0.f;
#pragma unroll
        for (int e = 0; e < 2; ++e)
#pragma unroll
            for (int i = 0; i < 16; ++i) o[mp][e][i] = 0.f; }
    const int qw0 = a.q0 + 32 * wid;
    MaskP mk; mk.qrow = qw0 >> 6; mk.qcol = (qw0 & 63) + r; mk.qpos = qw0 + r; mk.rpbl = (const LAS float*)(lds + OFF_RPB); mk.lt = 0;
    { int rs = mk.qrow - 4; mk.rs = rs < 0 ? 0 : (rs > 120 ? 120 : rs); int cs = mk.qcol - 8; mk.cs = cs < 0 ? 0 : (cs > 48 ? 48 : cs); }
#define ATT_ACTIVE(j) ((j) < 4 ? true : (MODE == 1 ? ((a.lt0 + (j) - 4 >= mk.rs) && (a.lt0 + (j) - 4 < mk.rs + 8)) : (MODE == 2 ? ((64 * (a.lt0 + (j) - 4) + 63 >= qw0 - 128) && (64 * (a.lt0 + (j) - 4) <= qw0 + 31 + 128)) : true)))
    const LAS unsigned char* vlane = lds + OFF_V + (4 * h + ((lane & 15) >> 2)) * VP + ((lane >> 4) & 1) * 32 + (lane & 3) * 8;
    f32x16 S[2]; bf16x8 pk[NMAP][2][2];
    ATT_STORE(0, 0, 0);
    __syncthreads();
#define ATT_BODY_A(IT, P) { ATT_LOAD(P, (IT) + 3); \
        if ((IT) < nt && ATT_ACTIVE(IT)) { mk.lt = a.lt0 + (IT) - 4; \
            if (NMAP == 1) { s16x4 lo_[4], hi_[4]; \
                att_qk<DQK, NMAP>(lds + ((IT) & 1) * KBUF, r, h, qf[0], 0, S); __builtin_amdgcn_sched_barrier(0); \
                att_vload(vlane + (P) * VBUF, 0, lo_, hi_); __builtin_amdgcn_sched_barrier(0);       \
                att_sm<MODE>(S, pk[0], mref[0], lrun[0], o[0], (IT) >= 4, mk, h); __builtin_amdgcn_sched_barrier(0); \
                att_pvmm<NMAP>(lo_, hi_, pk, o, 0); __builtin_amdgcn_sched_barrier(0); \
                att_vload(vlane + (P) * VBUF, 1, lo_, hi_); __builtin_amdgcn_sched_barrier(0); \
                att_pvmm<NMAP>(lo_, hi_, pk, o, 1); __builtin_amdgcn_sched_barrier(0); \
            } else { s16x4 lo_[4], hi_[4]; \
                att_qk<DQK, NMAP>(lds + ((IT) & 1) * KBUF, r, h, qf[0], 0, S); __builtin_amdgcn_sched_barrier(0); \
                att_sm<MODE>(S, pk[0], mref[0], lrun[0], o[0], (IT) >= 4, mk, h); __builtin_amdgcn_sched_barrier(0); \
                att_qk<DQK, NMAP>(lds + ((IT) & 1) * KBUF, r, h, qf[NMAP - 1], NMAP - 1, S); __builtin_amdgcn_sched_barrier(0); \
                att_vload(vlane + (P) * VBUF, 0, lo_, hi_); __builtin_amdgcn_sched_barrier(0); \
                att_sm_head<MODE>(S, mref[NMAP - 1], lrun[NMAP - 1], o[NMAP - 1], (IT) >= 4, mk, h); __builtin_amdgcn_sched_barrier(0); \
                  \
                att_pvmm1(lo_, hi_, pk[0], o[0][0]); att_sm_tail(S, pk[NMAP - 1], mref[NMAP - 1], lrun[NMAP - 1]); \
                __builtin_amdgcn_sched_group_barrier(0x8, 1, 0); __builtin_amdgcn_sched_group_barrier(0x2, 20, 0); \
                __builtin_amdgcn_sched_group_barrier(0x8, 1, 0); __builtin_amdgcn_sched_group_barrier(0x2, 20, 0); \
                __builtin_amdgcn_sched_group_barrier(0x8, 1, 0); __builtin_amdgcn_sched_group_barrier(0x2, 20, 0); \
                __builtin_amdgcn_sched_group_barrier(0x8, 1, 0); __builtin_amdgcn_sched_group_barrier(0x2, 20, 0); \
                __builtin_amdgcn_sched_barrier(0); \
                att_pvmm1(lo_, hi_, pk[NMAP - 1], o[NMAP - 1][0]); __builtin_amdgcn_sched_barrier(0); \
                att_vload(vlane + (P) * VBUF, 1, lo_, hi_); __builtin_amdgcn_sched_barrier(0); \
                att_pvmm<NMAP>(lo_, hi_, pk, o, 1); __builtin_amdgcn_sched_barrier(0); } } \
        ATT_STORE(((P) + 1) % 3, ((IT) + 1) & 1, ((P) + 1) % 3); __syncthreads(); }
    __builtin_amdgcn_s_waitcnt(0x0F70);
    const int nt3 = ((nt + 2) / 3) * 3;
    for (int it = 0; it < nt3; it += 3) {
        ATT_BODY_A(it, 0);
        ATT_BODY_A(it + 1, 1);
        ATT_BODY_A(it + 2, 2);
    }
#undef ATT_BODY_A
#undef TILE_ROW
#undef ATT_LOAD
#undef ATT_STORE
#undef ATT_ACTIVE
    float inv[NMAP];
#pragma unroll
    for (int mp = 0; mp < NMAP; ++mp) { const float lt_ = lrun[mp] + __shfl_xor(lrun[mp], 32); inv[mp] = 1.0f / lt_; }
    f32x16 y[2];
    if (NMAP == 1) {
#pragma unroll
        for (int e = 0; e < 2; ++e)
#pragma unroll
            for (int i = 0; i < 16; ++i) y[e][i] = o[0][e][i] * inv[0];
    } else {
        float ss = 0.f; const float li = a.lam * inv[NMAP - 1];
#pragma unroll
        for (int e = 0; e < 2; ++e)
#pragma unroll
            for (int i = 0; i < 16; ++i) { const float v = o[0][e][i] * inv[0] - li * o[NMAP - 1][e][i]; y[e][i] = v; ss += v * v; }
        ss += __shfl_xor(ss, 32);
        const float rstd = rsqrtf(ss * (1.0f / 64.0f) + 1e-5f) * a.post;
#pragma unroll
        for (int e = 0; e < 2; ++e)
#pragma unroll
            for (int g4 = 0; g4 < 4; ++g4) { const f32x4 sg = *(const GAS f32x4*)(a.subln + 32 * e + 8 * g4 + 4 * h);
#pragma unroll
                for (int jj = 0; jj < 4; ++jj) y[e][4 * g4 + jj] *= rstd * sg[jj]; }
    }
    bf16_t* yp = a.Y + (size_t)(32 * wid + r) * a.ys + 8 * h;
#pragma unroll
    for (int e = 0; e < 2; ++e)
#pragma unroll
        for (int t = 0; t < 2; ++t) {
            const unsigned a0 = pk2(y[e][8 * t], y[e][8 * t + 1]), a1 = pk2(y[e][8 * t + 2], y[e][8 * t + 3]);
            const unsigned b0 = pk2(y[e][8 * t + 4], y[e][8 * t + 5]), b1 = pk2(y[e][8 * t + 6], y[e][8 * t + 7]);
            const auto r0 = __builtin_amdgcn_permlane32_swap(a0, b0, false, false), r1 = __builtin_amdgcn_permlane32_swap(a1, b1, false, false);
            u32x4 w; w.x = r0[0]; w.y = r1[0]; w.z = r0[1]; w.w = r1[1];
            *(GAS u32x4*)(yp + 32 * e + 16 * t) = w; }
}

struct Params { const float* in[27]; float* out; unsigned char* ws; };

struct ConvJob { const float* src; int K, N; bf16_t* dst; int ldd, koff, rowoff, mode; const float* kgain; int sn0, sn1; float scale; };
DI void conv_item(const ConvJob& J, LAS float* scr, int item, int lane) {
    const int nblk = J.N / 32, kb = item / nblk, nb = item % nblk, k0 = 64 * kb, n0 = 32 * nb;
    { float tv[32];
#pragma unroll
      for (int i = 0; i < 32; ++i) tv[i] = ((const GAS float*)J.src)[(size_t)(k0 + 2 * i + (lane >> 5)) * J.N + n0 + (lane & 31)];
#pragma unroll
      for (int i = 0; i < 32; ++i) scr[(2 * i + (lane >> 5)) * 33 + (lane & 31)] = tv[i]; }
    asm volatile("s_waitcnt lgkmcnt(0)" ::: "memory");
    const int c = lane & 7;
    float gk[8];
#pragma unroll
    for (int q = 0; q < 8; ++q) gk[q] = J.kgain ? J.kgain[k0 + 8 * c + q] : 1.0f;
#pragma unroll
    for (int j = 0; j < 4; ++j) { const int nl = (lane >> 3) + 8 * j, n = n0 + nl; const LAS float* s = scr + (8 * c) * 33 + nl;
        const float sc = (n >= J.sn0 && n < J.sn1) ? J.scale : 1.0f;
        int row = n;
        if (J.mode == 1) { const int hu = (n < DFF) ? n : n - DFF; row = 256 * (hu >> 7) + 64 * ((hu >> 5) & 3) + (hu & 31) + ((n < DFF) ? 0 : 32); }
        u32x4 o; o.x = pk2(s[0 * 33] * gk[0] * sc, s[1 * 33] * gk[1] * sc); o.y = pk2(s[2 * 33] * gk[2] * sc, s[3 * 33] * gk[3] * sc);
        o.z = pk2(s[4 * 33] * gk[4] * sc, s[5 * 33] * gk[5] * sc); o.w = pk2(s[6 * 33] * gk[6] * sc, s[7 * 33] * gk[7] * sc);
        *(u32x4*)(J.dst + (size_t)(J.rowoff + row) * J.ldd + J.koff + k0 + 8 * c) = o; }
    asm volatile("s_waitcnt lgkmcnt(0)" ::: "memory");
}

DI bool get_conv_job(LAS unsigned char* lds, int l, int j, ConvJob& J) {
    unsigned char* wl = WSP_ + WS_W + (size_t)l * WL;
    J.kgain = nullptr; J.sn0 = 0; J.sn1 = 0; J.scale = 1.f; J.koff = 0; J.rowoff = 0; J.mode = 0;
    switch (j) {
    case 0: J.src = INP_(7) + (size_t)l * DM * 2 * DFF; J.K = DM; J.N = 2 * DFF; J.dst = (bf16_t*)(wl + W_GU1); J.ldd = DM; J.mode = 1; return true;
    case 1: J.src = INP_(8) + (size_t)l * DFF * DM; J.K = DFF; J.N = DM; J.dst = (bf16_t*)(wl + W_DN1); J.ldd = DFF; return true;
    case 2: J.src = INP_(24) + (size_t)l * DM * 2 * DFF; J.K = DM; J.N = 2 * DFF; J.dst = (bf16_t*)(wl + W_GU2); J.ldd = DM; J.mode = 1; return true;
    case 3: J.src = INP_(25) + (size_t)l * DFF * DM; J.K = DFF; J.N = DM; J.dst = (bf16_t*)(wl + W_DN2); J.ldd = DFF; return true;
    case 4: J.src = INP_(10) + (size_t)l * DM * C_END; J.K = DM; J.N = C_END; J.dst = (bf16_t*)(wl + W_IN); J.ldd = DM; J.sn0 = C_NQ; J.sn1 = C_NK; J.scale = SC_C; return true;
    case 5: J.src = INP_(12) + (size_t)l * 256 * 384; J.K = 256; J.N = 384; J.dst = (bf16_t*)(wl + W_MLA); J.ldd = 384; J.kgain = INP_(11) + l * 256; return true;
    case 6: J.src = INP_(14) + (size_t)l * 128 * 512; J.K = 128; J.N = 512; J.dst = (bf16_t*)(wl + W_MLA); J.ldd = 384; J.koff = 256; J.rowoff = 384; J.kgain = INP_(13) + l * 128; return true;
    case 7: case 8: case 9: case 10: { const int i = j - 7; J.src = INP_(20) + ((size_t)l * 4 + i) * DM * DM; J.K = DM; J.N = DM; J.dst = (bf16_t*)(wl + W_GATE) + (size_t)i * DM * DM; J.ldd = DM; return true; }
    case 11: case 12: case 13: case 14: { const int i = j - 11; J.src = INP_(19) + ((size_t)l * 4 + i) * 256 * DM; J.K = 256; J.N = DM; J.dst = (bf16_t*)(wl + W_BR) + (size_t)i * DM * 256; J.ldd = 256; return true; }
    case 15: J.src = INP_(22) + (size_t)l * DM * DM; J.K = DM; J.N = DM; J.dst = (bf16_t*)(wl + W_OUT); J.ldd = DM; return true;
    default: return false;
    }
}

DI void prologue_phase(LAS unsigned char* lds, int G) {
    const int tid = opaque_tid(), lane = tid & 63, wave = tid >> 6, bid = opaque_bid();
    const int gw = bid * NWAVES + wave, NGW = G * NWAVES;
    LAS float* stab = (LAS float*)lds;
    unsigned char* const ws = WSP_; const float* const cin = INP_(1); const float* const ccin = INP_(3); const float* const wada = INP_(4); const float* const bada = INP_(5);
    for (int i = tid; i < 9 * DM; i += NTHR) { const float v = (i < 8 * DM) ? cin[i] : ccin[i - 8 * DM]; stab[i] = v * fast_rcp(1.0f + __expf(-v)); }
    __syncthreads();
    { float* MOD = (float*)(ws + WS_MOD); const int kq = lane >> 4, cc = lane & 15;
      for (int it = gw; it < 2 * 576; it += NGW) { const int l = it / 576, col = (it % 576) * 16 + cc;
          const float* w = wada + (size_t)l * DM * 9216 + col; float acc[9];
#pragma unroll
          for (int v = 0; v < 9; ++v) acc[v] = 0.f;
#pragma unroll 8
          for (int k = kq; k < DM; k += 4) { const float wv = w[(size_t)k * 9216];
#pragma unroll
              for (int v = 0; v < 9; ++v) acc[v] += stab[v * DM + k] * wv; }
#pragma unroll
          for (int v = 0; v < 9; ++v) { acc[v] += __shfl_xor(acc[v], 16); acc[v] += __shfl_xor(acc[v], 32); }
          if (kq == 0) { const float bb = bada[l * 9216 + col];
#pragma unroll
              for (int v = 0; v < 9; ++v) MOD[((size_t)l * 9 + v) * 9216 + col] = acc[v] + bb; } } }
    __syncthreads();
    { float* T32 = (float*)(ws + WS_TAB); float* T64 = T32 + 128 * 8 * 2; float* SCL = T64 + 128 * 16 * 2;
      const int gt = bid * NTHR + tid;
      if (gt < 128 * 8) { const int pos = gt >> 3, i = gt & 7; float t = (float)pos * (exp2f(-(float)i * (13.287712379549449f / 8.0f)) * 0.15915494309189535f); t -= rintf(t);
          T32[2 * gt] = __builtin_amdgcn_cosf(t); T32[2 * gt + 1] = __builtin_amdgcn_sinf(t); }
      else if (gt < 128 * 8 + 128 * 16) { const int g2 = gt - 128 * 8, pos = g2 >> 4, i = g2 & 15; float t = (float)pos * (exp2f(-(float)i * (13.287712379549449f / 16.0f)) * 0.15915494309189535f); t -= rintf(t);
          T64[2 * g2] = __builtin_amdgcn_cosf(t); T64[2 * g2 + 1] = __builtin_amdgcn_sinf(t); }
      else if (gt < 128 * 24 + 2) { const int l = gt - 128 * 24; const float* dl = INP_(15) + l * 128; float a0 = 0.f, a1 = 0.f;
          for (int i = 0; i < 32; ++i) { a0 += dl[i] * dl[32 + i]; a1 += dl[64 + i] * dl[96 + i]; }
          const float lam_init = 0.8f - 0.6f * __expf(-0.3f * (float)l);
          SCL[2 * l] = __expf(a0) - __expf(a1) + lam_init; SCL[2 * l + 1] = 1.0f - lam_init; } }
    for (int l = 0; l < 2; ++l) { unsigned char* wl = ws + WS_W + (size_t)l * WL;
        u32x4* zin = (u32x4*)(wl + W_IN + (size_t)C_END * DM * 2); const int nzin = (INP - C_END) * DM * 2 / 16;
        for (int i = bid * NTHR + tid; i < nzin; i += G * NTHR) zin[i] = (u32x4){0, 0, 0, 0};
        bf16_t* wm = (bf16_t*)(wl + W_MLA);
        for (int i = bid * NTHR + tid; i < 1024 * 384 / 8; i += G * NTHR) { const int row = i / 48, k8 = (i % 48) * 8;
            const bool z = (row < 384) ? (k8 >= 256) : (row < 896 ? (k8 < 256) : true);
            if (z) *(u32x4*)(wm + (size_t)row * 384 + k8) = (u32x4){0, 0, 0, 0}; } }
    { LAS float* scr = (LAS float*)(lds + wave * 16384); int rot = 0;
      for (int j = 0; j < 16; ++j) { ConvJob J; get_conv_job(lds, 0, j, J); const int nit = (J.K / 64) * (J.N / 32);
          int start = gw - rot; start %= NGW; if (start < 0) start += NGW;
          for (int it = start; it < nit; it += NGW) conv_item(J, scr, it, lane);
          rot = (rot + nit) % NGW; } }
}
DI void conv_tail_fill(LAS unsigned char* lds, int G) {
    const int tid = opaque_tid(), lane = tid & 63, wave = tid >> 6, bid = opaque_bid();
    const int nskip = (G > 64) ? 32 : 0;
    if (bid < nskip) return;
    const int gw = (bid - nskip) * NWAVES + wave, NGW = (G - nskip) * NWAVES;
    LAS float* scr = (LAS float*)(lds + wave * 16384); int rot = 0;
    for (int j = 0; j < 16; ++j) { ConvJob J; get_conv_job(lds, 1, j, J); const int nit = (J.K / 64) * (J.N / 32);
        int start = gw - rot; start %= NGW; if (start < 0) start += NGW;
        for (int it = start; it < nit; it += NGW) conv_item(J, scr, it, lane);
        rot = (rot + nit) % NGW; }
}

DI void nm_phase(const float* src_lat, const float* src_ctx, const float* gain, const float* modl, int ch_shift, int ch_scale, bf16_t* U, int M, int G, int row_lo = 0, int wg_lo = 0) {
    const int tid_ = opaque_tid(), lane = tid_ & 63, wave = tid_ >> 6, bid_ = opaque_bid();
    if (bid_ < wg_lo) return;
    const int gw = (bid_ - wg_lo) * NWAVES + wave, NGW = (G - wg_lo) * NWAVES;
    f32x4 gv[4];
#pragma unroll
    for (int j = 0; j < 4; ++j) gv[j] = *((const GAS f32x4*)gain + lane + 64 * j);
    for (int row0 = row_lo + gw; row0 < M; row0 += 2 * NGW) {
        const int row1 = row0 + NGW; const bool two = row1 < M;
        const float* xr0 = (row0 < MLAT) ? src_lat + (size_t)row0 * DM : src_ctx + (size_t)(row0 - MLAT) * DM;
        const float* xr1 = two ? ((row1 < MLAT) ? src_lat + (size_t)row1 * DM : src_ctx + (size_t)(row1 - MLAT) * DM) : xr0;
        f32x4 v0[4], v1[4]; float s0 = 0.f, s1 = 0.f;
#pragma unroll
        for (int j = 0; j < 4; ++j) { v0[j] = __builtin_nontemporal_load((const GAS f32x4*)xr0 + lane + 64 * j); v1[j] = __builtin_nontemporal_load((const GAS f32x4*)xr1 + lane + 64 * j); }
#pragma unroll
        for (int j = 0; j < 4; ++j) { s0 += (v0[j].x * v0[j].x + v0[j].y * v0[j].y) + (v0[j].z * v0[j].z + v0[j].w * v0[j].w); s1 += (v1[j].x * v1[j].x + v1[j].y * v1[j].y) + (v1[j].z * v1[j].z + v1[j].w * v1[j].w); }
        const float rstd0 = rsqrtf(wave_sum(s0) * (1.0f / DM) + 1e-6f), rstd1 = rsqrtf(wave_sum(s1) * (1.0f / DM) + 1e-6f);
        const int vec0 = (row0 < MLAT) ? (row0 >> 13) : 8, vec1 = two ? ((row1 < MLAT) ? (row1 >> 13) : 8) : vec0;
        const float* mv0 = modl + (size_t)vec0 * 9216; const float* mv1 = modl + (size_t)vec1 * 9216;
        f32x4 sh0[4], sc0[4], sh1[4], sc1[4];
#pragma unroll
        for (int j = 0; j < 4; ++j) { sh0[j] = *((const GAS f32x4*)(mv0 + ch_shift * 1024) + lane + 64 * j); sc0[j] = *((const GAS f32x4*)(mv0 + ch_scale * 1024) + lane + 64 * j);
            sh1[j] = *((const GAS f32x4*)(mv1 + ch_shift * 1024) + lane + 64 * j); sc1[j] = *((const GAS f32x4*)(mv1 + ch_scale * 1024) + lane + 64 * j); }
        { bf16_t* ur = U + (size_t)row0 * DM;
#pragma unroll
          for (int j = 0; j < 4; ++j) { const f32x4 o = v0[j] * rstd0 * gv[j] * (sc0[j] + 1.0f) + sh0[j]; u32x2 w; w.x = pk2(o.x, o.y); w.y = pk2(o.z, o.w); *((GAS u32x2*)ur + lane + 64 * j) = w; } }
        if (two) { bf16_t* ur = U + (size_t)row1 * DM;
#pragma unroll
          for (int j = 0; j < 4; ++j) { const f32x4 o = v1[j] * rstd1 * gv[j] * (sc1[j] + 1.0f) + sh1[j]; u32x2 w; w.x = pk2(o.x, o.y); w.y = pk2(o.z, o.w); *((GAS u32x2*)ur + lane + 64 * j) = w; } }
    }
}

DI void final_phase(float* H, const float* gain, int G) {
    const int tid_ = opaque_tid(), lane = tid_ & 63, wave = tid_ >> 6, gw = opaque_bid() * NWAVES + wave, NGW = G * NWAVES;
    f32x4 gv[4];
#pragma unroll
    for (int j = 0; j < 4; ++j) gv[j] = *((const GAS f32x4*)gain + lane + 64 * j);
    for (int row = gw; row < MLAT; row += NGW) { float* xr = H + (size_t)row * DM; f32x4 v[4]; float s = 0.f;
#pragma unroll
        for (int j = 0; j < 4; ++j) { v[j] = *((const GAS f32x4*)xr + lane + 64 * j); s += (v[j].x * v[j].x + v[j].y * v[j].y) + (v[j].z * v[j].z + v[j].w * v[j].w); }
        const float rstd = rsqrtf(wave_sum(s) * (1.0f / DM) + 1e-6f);
#pragma unroll
        for (int j = 0; j < 4; ++j) *((GAS f32x4*)xr + lane + 64 * j) = v[j] * rstd * gv[j]; }
}

DI void unpack8(const u32x4 w, float (&x)[8]) {
    x[0] = __uint_as_float(w.x << 16); x[1] = __uint_as_float(w.x & 0xffff0000u); x[2] = __uint_as_float(w.y << 16); x[3] = __uint_as_float(w.y & 0xffff0000u);
    x[4] = __uint_as_float(w.z << 16); x[5] = __uint_as_float(w.z & 0xffff0000u); x[6] = __uint_as_float(w.w << 16); x[7] = __uint_as_float(w.w & 0xffff0000u);
}
DI u32x4 pack8(const float (&x)[8]) { u32x4 w; w.x = pk2(x[0], x[1]); w.y = pk2(x[2], x[3]); w.z = pk2(x[4], x[5]); w.w = pk2(x[6], x[7]); return w; }
DI u32x4 rope_math(const u32x4 xw, const u32x4 pw, const f32x4 (&tb)[4], float sgn, float scale) {
    float x[8], xp[8], o[8]; unpack8(xw, x); unpack8(pw, xp);
#pragma unroll
    for (int q = 0; q < 4; ++q) { const f32x4 cs = tb[q];
        o[2 * q] = (x[2 * q] * cs[0] + sgn * xp[2 * q] * cs[1]) * scale; o[2 * q + 1] = (x[2 * q + 1] * cs[2] + sgn * xp[2 * q + 1] * cs[3]) * scale; }
    return pack8(o);
}
DI void derive_phase(LAS unsigned char* lds, int G) {
    const int tid_ = opaque_tid(), lane = tid_ & 63, wave = tid_ >> 6, gw = opaque_bid() * NWAVES + wave, NGW = G * NWAVES;
    unsigned char* const ws = WSP_;
    const GAS bf16_t* PB = (const GAS bf16_t*)(ws + WS_S + S_P); const GAS bf16_t* RB = (const GAS bf16_t*)(ws + WS_S + S_R);
    unsigned char* der = ws + WS_S + S_DER;
    GAS bf16_t *QA = (GAS bf16_t*)(der + D_QA), *KA = (GAS bf16_t*)(der + D_KA), *VA = (GAS bf16_t*)(der + D_VA), *QB = (GAS bf16_t*)(der + D_QB), *KB = (GAS bf16_t*)(der + D_KB), *QD = (GAS bf16_t*)(der + D_QD), *KD = (GAS bf16_t*)(der + D_KD);
    const GAS float* T32 = (const GAS float*)(ws + WS_TAB); const GAS float* T64 = T32 + 128 * 8 * 2;
    const int hh = (lane >> 3) & 3, cc = lane & 7;
    const bool q1 = lane < 32;
    const int c3 = lane & 31, e3 = (8 * c3) & 31;
    const bool q4 = (lane & 31) < 16; const int h4 = (lane >> 2) & 3, c4 = lane & 3, e4 = 8 * c4;
    const int c5 = q1 ? lane : lane - 32, e5 = (8 * c5) & 63;
    for (int row = gw; row < MALL; row += NGW) {
        const bool lat = row < MLAT; const int t = row & (SEQ - 1); const int prow = lat ? (t >> 6) : 0, pcol = lat ? (t & 63) : 0;
        const GAS bf16_t* p = PB + (size_t)row * INP; const GAS bf16_t* rr = RB + (size_t)row * DM;
        const u32x4 w0 = *(const GAS u32x4*)(p + (lane < 32 ? C_CQ + lane * 8 : C_CKV + ((lane - 32) & 15) * 8));
        const u32x4 a1 = *(const GAS u32x4*)(q1 ? rr + hh * 96 + cc * 8 : rr + 384 + hh * 128 + cc * 8);
        const u32x4 a2 = *(const GAS u32x4*)(rr + 384 + hh * 128 + 64 + cc * 8);
        const GAS bf16_t* b3 = p + (q1 ? C_DQ : C_DK);
        const u32x4 x3 = *(const GAS u32x4*)(b3 + 8 * c3), p3 = *(const GAS u32x4*)(b3 + 8 * (c3 ^ 1));
        const GAS bf16_t* b4 = q4 ? rr + h4 * 96 + 64 : p + C_KR;
        const u32x4 x4 = *(const GAS u32x4*)(b4 + 8 * c4), p4 = *(const GAS u32x4*)(b4 + 8 * (c4 ^ 1));
        const GAS bf16_t* b5 = p + (q1 ? C_GQ : C_GK);
        const u32x4 x5 = *(const GAS u32x4*)(b5 + 8 * c5), p5 = *(const GAS u32x4*)(b5 + 8 * (c5 ^ 2));
        f32x4 t3[4], t4[4], t5[4];
        { const GAS f32x4* a = (const GAS f32x4*)(T32 + (((e3 & 16) ? pcol : prow)) * 16); const GAS f32x4* b = (const GAS f32x4*)(T32 + (((e4 & 16) ? pcol : prow)) * 16);
          const GAS f32x4* c = (const GAS f32x4*)(T64 + ((((e5 & 32) ? pcol : prow)) * 16 + (e5 & 8)) * 2);
#pragma unroll
          for (int q = 0; q < 4; ++q) { t3[q] = a[q]; t4[q] = b[q]; t5[q] = c[q]; } }
        float sq = 0.f, skv = 0.f;
        { float x[8]; unpack8(w0, x); float a = 0.f;
#pragma unroll
          for (int q = 0; q < 8; ++q) a += x[q] * x[q];
          if (lane < 32) sq = a; else if (lane < 48) skv = a; }
        const float rq = rsqrtf(wave_sum(sq) * (1.0f / 256.0f) + 1e-6f), rkv = rsqrtf(wave_sum(skv) * (1.0f / 128.0f) + 1e-6f);
        { const float sc = q1 ? rq * SC_A : rkv; float x[8]; unpack8(a1, x);
#pragma unroll
          for (int q = 0; q < 8; ++q) x[q] *= sc;
          *(GAS u32x4*)((q1 ? QA : KA) + (size_t)row * 384 + hh * 96 + cc * 8) = pack8(x); }
        if (lane < 32) { float x[8]; unpack8(a2, x);
#pragma unroll
            for (int q = 0; q < 8; ++q) x[q] *= rkv;
            *(GAS u32x4*)(VA + (size_t)row * 256 + lane * 8) = pack8(x); }
        *(GAS u32x4*)((q1 ? QB : KB) + (size_t)row * 256 + 8 * c3) = rope_math(x3, p3, t3, (e3 & 8) ? 1.0f : -1.0f, q1 ? SC_B : 1.0f);
        if (lane < 32) *(GAS u32x4*)((q4 ? QA : KA) + (size_t)row * 384 + h4 * 96 + 64 + 8 * c4) = rope_math(x4, p4, t4, (e4 & 8) ? 1.0f : -1.0f, q4 ? rq * SC_A : 1.0f);
        if (lane < 48) { const u32x4 w = rope_math(x5, p5, t5, (e5 & 16) ? 1.0f : -1.0f, q1 ? SC_D : 1.0f);
            if (q1) *(GAS u32x4*)(QD + (size_t)row * 256 + 8 * c5) = w; else *(GAS u32x4*)(KD + (size_t)row * 128 + 8 * c5) = w; }
    }
}

DI void attn_phase(LAS unsigned char* lds, int l, int G) {
    unsigned char* const ws = WSP_;
    const bf16_t* PB = (const bf16_t*)(ws + WS_S + S_P);
    unsigned char* der = ws + WS_S + S_DER;
    const bf16_t *QA = (const bf16_t*)(der + D_QA), *KA = (const bf16_t*)(der + D_KA), *VA = (const bf16_t*)(der + D_VA), *QB = (const bf16_t*)(der + D_QB), *KB = (const bf16_t*)(der + D_KB),
                 *QD = (const bf16_t*)(der + D_QD), *KD = (const bf16_t*)(der + D_KD);
    bf16_t* Y = (bf16_t*)(ws + WS_S + S_Y);
    const float* SCL = (const float*)(ws + WS_TAB) + 128 * 24 * 2;
    const float lam = SCL[2 * l], post = SCL[2 * l + 1];
    const int bx = opaque_bid(); const int vc = (G % 8 == 0) ? ((bx % 8) * (G / 8) + bx / 8) : bx;
    const int nunits = 4096 + (l == 0 ? 128 : 0);
    for (int id = vc; id < nunits; id += G) {
        AttnU a; a.m0 = -1e30f; a.l0 = 0.f; a.rpb = nullptr; a.lam = lam; a.post = post; a.subln = INP_(16) + l * 64; a.ys = DM;
        int br, b, hh, qb; bool isctx = false;
        if (id < 4096) { br = id >> 10; const int rem = id & 1023; b = rem >> 7; hh = (rem >> 5) & 3; qb = rem & 31; }
        else { const int c = id - 4096; br = c >> 5; b = (c >> 2) & 7; hh = c & 3; qb = 0; isctx = true; }
        const size_t qrow = isctx ? (size_t)(MLAT + b * CTX) : (size_t)(b * SEQ + qb * 256);
        a.b = b; a.q0 = qb * 256; a.lt0 = 0; a.lt1 = isctx ? 0 : 128;
        a.Y = Y + qrow * DM + br * 256 + hh * 64;
        if (br == 0) { a.Q = QA + qrow * 384 + hh * 96; a.qs = 384; a.K = KA + hh * 96; a.ks = 384; a.V = VA + hh * 64; a.vs = 256;
            attn_unit<96, 1, 0>(lds, a); }
        else if (br == 1) { a.Q = QB + qrow * 256 + hh * 64; a.qs = 256; a.K = KB + hh * 64; a.ks = 256; a.V = PB + C_DV + hh * 64; a.vs = INP;
            attn_unit<64, 2, 0>(lds, a); }
        else if (br == 2) { a.Q = PB + qrow * INP + C_NQ + hh * 64; a.qs = INP; a.K = PB + C_NK + hh * 64; a.ks = INP; a.V = PB + C_NV + hh * 64; a.vs = INP;
            if (isctx) attn_unit<64, 1, 0>(lds, a);
            else { const int r0 = qb * 4; int lo = r0 - 4; lo = lo < 0 ? 0 : (lo > 120 ? 120 : lo); int hi = r0 + 3 - 4; hi = hi < 0 ? 0 : (hi > 120 ? 120 : hi);
                a.lt0 = lo; a.lt1 = hi + 8; a.rpb = INP_(17) + ((size_t)l * 4 + hh) * 465; attn_unit<64, 1, 1>(lds, a); } }
        else { a.Q = QD + qrow * 256 + hh * 64; a.qs = 256; a.K = KD + (hh >> 1) * 64; a.ks = 128; a.V = PB + C_GV + (hh >> 1) * 64; a.vs = INP;
            a.m0 = INP_(18)[l * 4 + hh] * LOG2E; a.l0 = 1.0f;
            if (!isctx) { int lo = a.q0 - 128; lo = lo < 0 ? 0 : lo; int hi = a.q0 + 256 + 128; hi = hi > SEQ ? SEQ : hi; a.lt0 = lo >> 6; a.lt1 = hi >> 6; }
            attn_unit<64, 1, 2>(lds, a); }
    }
}


constexpr size_t WS_BAR = WS_TAB + 512 * 1024;
#define XB_TMO      128
#define XB_XCNT(j)  (256  + 64 * (j))
#define XB_XSUB(j)  (1280 + 64 * (j))
#define XB_XGEN(j)  (2304 + 64 * (j))
#define XB_TOP      3328
#define XB_TOPGEN   3392
#define XCD_BAR_WORDS 3456
#define XB_SPIN_CAP (1u << 22)
DI unsigned xb_ld(unsigned* p)              { return __hip_atomic_load(p, __ATOMIC_RELAXED, __HIP_MEMORY_SCOPE_AGENT); }
DI unsigned xb_add(unsigned* p, unsigned v) { return __hip_atomic_fetch_add(p, v, __ATOMIC_RELAXED, __HIP_MEMORY_SCOPE_AGENT); }
DI unsigned xb_xcc_id() { return (unsigned)__builtin_amdgcn_s_getreg((3 << 11) | 20) & 0xFu; }
#define XB_SPIN(cond, bar) do { unsigned _sp = 0; while (cond) { __builtin_amdgcn_s_sleep(1); \
    if ((++_sp & 255u) == 0u) { if (xb_ld(&(bar)[XB_TMO])) break; if (_sp > XB_SPIN_CAP) { atomicAdd(&(bar)[XB_TMO], 1u); break; } } } } while (0)
struct XcdBarrier { unsigned* bar; unsigned x; volatile LAS unsigned* st; };
DI XcdBarrier xcd_barrier_post(unsigned* bar, volatile LAS unsigned* st) {
    XcdBarrier b; b.bar = bar; b.x = xb_xcc_id(); b.st = st;
    if (threadIdx.x == 0) (void)xb_add(&bar[XB_XCNT(b.x)], 1u);
    return b;
}
DI void xcd_barrier_complete(unsigned* bar, unsigned x, unsigned& nloc, unsigned& nx) {
    const unsigned G = gridDim.x * gridDim.y * gridDim.z;
    unsigned sum, cnt, mine, sp = 0u;
    for (;;) {
        sum = 0u; cnt = 0u; mine = 0u;
#pragma unroll
        for (unsigned j = 0; j < 16; ++j) { const unsigned c = xb_ld(&bar[XB_XCNT(j)]); sum += c; cnt += (c > 0u) ? 1u : 0u; mine = (j == x) ? c : mine; }
        if (sum == G) break;
        __builtin_amdgcn_s_sleep(1);
        if ((++sp & 255u) == 0u) { if (xb_ld(&bar[XB_TMO])) break; if (sp > XB_SPIN_CAP) { atomicAdd(&bar[XB_TMO], 1u); break; } }
    }
    nloc = mine > 0u ? mine : 1u; nx = cnt > 0u ? cnt : 1u;
}
DI void xcd_barrier(const XcdBarrier& b) {
    asm volatile("s_waitcnt vmcnt(0)" ::: "memory");
    __syncthreads();
    if (threadIdx.x == 0) {
        unsigned* bar = b.bar; asm volatile("" : "+s"(bar));
        unsigned bx_ = b.x; asm volatile("" : "+s"(bx_));
        __builtin_amdgcn_s_waitcnt(0);
        unsigned nloc = b.st[0], nx = b.st[1];
        if (nloc == 0u) { xcd_barrier_complete(bar, bx_, nloc, nx); b.st[0] = nloc; b.st[1] = nx; }
        const unsigned old = xb_add(&bar[XB_XSUB(bx_)], 1u);
        const unsigned gen = old / nloc;
        if (old + 1u == (gen + 1u) * nloc) {
            __builtin_amdgcn_fence(__ATOMIC_RELEASE, "agent");
            asm volatile("s_waitcnt vmcnt(0)" ::: "memory");
            const unsigned og = xb_add(&bar[XB_TOP], 1u);
            const unsigned tg = og / nx;
            if (og + 1u == (tg + 1u) * nx) xb_add(&bar[XB_TOPGEN], 1u);
            else XB_SPIN(xb_ld(&bar[XB_TOPGEN]) == tg, bar);
            __builtin_amdgcn_fence(__ATOMIC_ACQUIRE, "agent");
            xb_add(&bar[XB_XGEN(bx_)], 1u);
            asm volatile("s_waitcnt vmcnt(0)" ::: "memory");
        } else {
            XB_SPIN(xb_ld(&bar[XB_XGEN(bx_)]) == gen, bar);
            __builtin_amdgcn_fence(__ATOMIC_ACQUIRE, "agent");
            asm volatile("s_waitcnt vmcnt(0)" ::: "memory");
        }
    }
    __syncthreads();
}

constexpr int LDS_BYTES = 136 * 1024;
constexpr int STEPS_PER_LAYER = 20, NSTEPS = 2 * STEPS_PER_LAYER + 1;

__global__ void __launch_bounds__(NTHR, 2) mega_fwd(Params P) {
    extern __shared__ __attribute__((aligned(16))) unsigned char lds_raw[];
    LAS unsigned char* lds = (LAS unsigned char*)lds_raw;
    cg::grid_group grid = cg::this_grid();
    const int G = gridDim.x;
    {
        volatile LAS unsigned long long* tab = (volatile LAS unsigned long long*)(lds + CTLO); const int t = threadIdx.x;
#define TAB_(k) if (t == (k)) tab[k] = (unsigned long long)P.in[k];
        TAB_(0) TAB_(1) TAB_(2) TAB_(3) TAB_(4) TAB_(5) TAB_(6) TAB_(7) TAB_(8) TAB_(9) TAB_(10) TAB_(11) TAB_(12) TAB_(13) TAB_(14) TAB_(15) TAB_(16) TAB_(17) TAB_(18) TAB_(19)
        TAB_(20) TAB_(21) TAB_(22) TAB_(23) TAB_(24) TAB_(25) TAB_(26)
#undef TAB_
        if (t == 27) tab[27] = (unsigned long long)P.out;
        if (t == 28) tab[28] = (unsigned long long)P.ws;
        if (t == 29) { volatile LAS unsigned* st = (volatile LAS unsigned*)(lds + CTLO + 512); st[0] = 0u; st[1] = 0u; }
    }
    __syncthreads();
    const XcdBarrier xbar = xcd_barrier_post((unsigned*)(P.ws + WS_BAR), (volatile LAS unsigned*)(lds + CTLO + 512));

    prologue_phase(lds, G);
    grid.sync();

    bool skip_nm = false;
    for (int st = 0; st < NSTEPS; ++st) {
        unsigned char* const ws = WSP_;
        float* const H = OUTP_; float* const HC = (float*)(ws + WS_HC);
        bf16_t* const U = (bf16_t*)(ws + WS_U);
        bf16_t* const FFH = (bf16_t*)(ws + WS_S + S_FFH); bf16_t* const PBUF = (bf16_t*)(ws + WS_S + S_P); bf16_t* const RBUF = (bf16_t*)(ws + WS_S + S_R);
        bf16_t* const YB = (bf16_t*)(ws + WS_S + S_Y); bf16_t* const BRB = (bf16_t*)(ws + WS_S + S_BR); bf16_t* const MG = (bf16_t*)(ws + WS_S + S_MG);
        if (st == NSTEPS - 1) { final_phase(H, INP_(26), G); break; }
        const int l = st / STEPS_PER_LAYER, j = st % STEPS_PER_LAYER;
        const unsigned char* wl = ws + WS_W + (size_t)l * WL;
        const float* modl = (const float*)(ws + WS_MOD) + (size_t)l * 9 * 9216;
        const bool last = (l == 1);
        const int Mpost = last ? MLAT : MALL;
        bool is_gemm = false; pg8::Gemm g{}; pg8::Epi E{}; int M = MALL;
        const bool nm_skipped = skip_nm && (j == 0 || j == 3 || j == 17); if (nm_skipped) skip_nm = false;
        switch (nm_skipped ? 99 : j) {
        case 0: {
            const float* sl = (l == 0) ? INP_(0) : H; const float* sc = (l == 0) ? INP_(2) : HC;
            nm_phase(sl, sc, INP_(6) + l * DM, modl, 0, 1, U, MALL, G); break; }
        case 1: case 18: {
            is_gemm = true; M = (j == 1) ? MALL : Mpost; g = pg8::Gemm{U, (const bf16_t*)(wl + (j == 1 ? W_GU1 : W_GU2)), M, 2 * DFF, DM, DM};
            E.mode = 1; E.perm = true; E.O = FFH; E.ldc = DFF; break; }
        case 2: case 19: {
            is_gemm = true; M = (j == 2) ? MALL : Mpost; g = pg8::Gemm{FFH, (const bf16_t*)(wl + (j == 2 ? W_DN1 : W_DN2)), M, DM, DFF, DFF};
            E.mode = 2; E.perm = false; const bool first = (l == 0 && j == 2);
            E.base_lat = first ? INP_(0) : H; E.base_ctx = first ? INP_(2) : HC; E.out_lat = H; E.out_ctx = HC; E.modp = modl; E.gate_chunk = (j == 2) ? 2 : 8; E.gs = 0.5f; break; }
        case 3: nm_phase(H, HC, INP_(9) + l * DM, modl, 3, 4, U, MALL, G); break;
        case 4: { is_gemm = true; M = MALL; g = pg8::Gemm{U, (const bf16_t*)(wl + W_IN), M, INP, DM, DM}; E.mode = 0; E.perm = true; E.O = PBUF; E.ldc = INP; break; }
        case 5: { is_gemm = true; M = MALL; g = pg8::Gemm{PBUF, (const bf16_t*)(wl + W_MLA), M, 1024, 384, INP}; E.mode = 0; E.perm = true; E.O = RBUF; E.ldc = DM; break; }
        case 6: derive_phase(lds, G); break;
        case 7: attn_phase(lds, l, G); break;
        case 8: case 10: case 12: case 14: { const int i = (j - 8) >> 1;
            is_gemm = true; M = Mpost; g = pg8::Gemm{YB + 256 * i, (const bf16_t*)(wl + W_BR) + (size_t)i * DM * 256, M, DM, 256, DM}; E.mode = 0; E.perm = true; E.O = BRB; E.ldc = DM; break; }
        case 9: case 11: case 13: case 15: { const int i = (j - 9) >> 1;
            is_gemm = true; M = Mpost; g = pg8::Gemm{U, (const bf16_t*)(wl + W_GATE) + (size_t)i * DM * DM, M, DM, DM, DM};
            E.mode = 3; E.perm = true; E.bias = INP_(21) + ((size_t)l * 4 + i) * DM; E.BR = BRB; E.MG = MG; E.gi = i; break; }
        case 16: { is_gemm = true; M = Mpost; g = pg8::Gemm{BRB, (const bf16_t*)(wl + W_OUT), M, DM, DM, DM};
            E.mode = 2; E.perm = false; E.base_lat = H; E.base_ctx = HC; E.out_lat = H; E.out_ctx = HC; E.modp = modl; E.gate_chunk = 5; E.gs = 1.0f; break; }
        case 17: nm_phase(H, HC, INP_(23) + l * DM, modl, 6, 7, U, Mpost, G); break;
        default: break;
        }
        const bool split = is_gemm && E.mode == 2 && M == MALL && G > 64;
        const int nsub = split ? 2 : 1;
        const bool eperm = E.perm;
        if (is_gemm) {
            E.row_off = 0;
            if (threadIdx.x == 0) { pg8::epi_store(lds, E);
                volatile LAS unsigned long long* gq = (volatile LAS unsigned long long*)(lds + CTL_EPI + 128);
                gq[0] = (unsigned long long)g.A; gq[1] = (unsigned long long)g.Bt; gq[2] = ((unsigned long long)(unsigned)g.N << 32) | (unsigned)g.K; gq[3] = ((unsigned long long)(unsigned)M << 32) | (unsigned)g.lda; }
        }
        for (int sub = 0; sub < nsub; ++sub) {
            if (is_gemm) {
                if (split && sub == 1 && threadIdx.x == 0) ((volatile LAS pg8::EpiL*)(lds + CTL_EPI))->row_off = (unsigned)MLAT;
                __syncthreads();
                pg8::Gemm gs; { const unsigned long long nk = lds_u64(lds, CTL_EPI + 128 + 16), ml = lds_u64(lds, CTL_EPI + 128 + 24);
                    gs.A = (const bf16_t*)lds_u64(lds, CTL_EPI + 128); gs.Bt = (const bf16_t*)lds_u64(lds, CTL_EPI + 128 + 8); gs.N = (int)(nk >> 32); gs.K = (int)(unsigned)nk; gs.M = (int)(ml >> 32); gs.lda = (int)(unsigned)ml; }
                if (split) { if (sub == 0) gs.M = MLAT; else { gs.A = gs.A + (size_t)MLAT * gs.lda; gs.M = MCTX; } }
                pg8::StaticOrder S; S.init(gs.M, gs.N, G, (int)blockIdx.x); pg8::gemm_phase(lds, gs, S, eperm);
                if (l == 0 && j == 15) conv_tail_fill(lds, G); }
            if (split) {
                const float* ngain; const float* nmod; int nsh, nsc;
                if (j == 2) { ngain = INP_(9) + l * DM; nmod = modl; nsh = 3; nsc = 4; }
                else if (j == 16) { ngain = INP_(23) + l * DM; nmod = modl; nsh = 6; nsc = 7; }
                else { ngain = INP_(6) + (l + 1) * DM; nmod = modl + 9 * 9216; nsh = 0; nsc = 1; }
                if (sub == 0) xcd_barrier(xbar);
                else { nm_phase(H, HC, ngain, nmod, nsh, nsc, U, MLAT, G, 0, 32);
                       xcd_barrier(xbar);
                       nm_phase(H, HC, ngain, nmod, nsh, nsc, U, MALL, G, MLAT, 0);
                       skip_nm = true; }
            }
        }
        const bool nosync = (j >= 8 && j <= 14) || nm_skipped;
        if (!nosync) xcd_barrier(xbar);
    }
}

extern "C" void kernel_launch(void* const* d_in, const int* in_sizes, int n_in, void* d_out, int out_size, void* d_ws, size_t ws_size, hipStream_t stream) {
    static int grid_blocks = 0;
    if (grid_blocks == 0) {
        if (n_in != 27 || ws_size < WS_END) { fprintf(stderr, "kernel_launch: unexpected inputs (n_in %d, ws %zu < %zu)\n", n_in, ws_size, (size_t)WS_END); grid_blocks = -1; return; }
        int dev = 0, cus = 0, per_cu = 0;
        hipGetDevice(&dev);
        hipDeviceGetAttribute(&cus, hipDeviceAttributeMultiprocessorCount, dev);
        hipFuncSetAttribute((const void*)mega_fwd, hipFuncAttributeMaxDynamicSharedMemorySize, LDS_BYTES);
        hipOccupancyMaxActiveBlocksPerMultiprocessor(&per_cu, (const void*)mega_fwd, NTHR, LDS_BYTES);
        if (per_cu < 1) { fprintf(stderr, "kernel_launch: occupancy query returned %d\n", per_cu); per_cu = 1; }
        grid_blocks = cus * 1;
        (void)hipGetLastError();
    }
    if (grid_blocks < 0) return;
    Params p{};
    for (int i = 0; i < 27; ++i) p.in[i] = (const float*)d_in[i];
    p.out = (float*)d_out; p.ws = (unsigned char*)d_ws;
    (void)hipMemsetAsync((unsigned char*)d_ws + WS_BAR, 0, XCD_BAR_WORDS * 4, stream);
    void* args[] = {&p};
    hipError_t e = hipLaunchCooperativeKernel((const void*)mega_fwd, dim3(grid_blocks), dim3(NTHR), args, LDS_BYTES, stream);
    if (e != hipSuccess) fprintf(stderr, "cooperative launch failed: %s (grid %d)\n", hipGetErrorString(e), grid_blocks);
}
```

```cpp
#include <hip/hip_runtime.h>
#include <hip/hip_cooperative_groups.h>
#include <cstdint>
#include <cstdio>
namespace cg = cooperative_groups;

#define LAS __attribute__((address_space(3)))
#define DI __device__ __forceinline__
#define GAS __attribute__((address_space(1)))
typedef unsigned short bf16_t;
typedef short bf16x8 __attribute__((ext_vector_type(8)));
typedef short s16x4 __attribute__((ext_vector_type(4)));
typedef float f32x2 __attribute__((ext_vector_type(2)));
typedef float f32x4 __attribute__((ext_vector_type(4)));
typedef float f32x16 __attribute__((ext_vector_type(16)));
typedef unsigned u32x2 __attribute__((ext_vector_type(2)));
typedef unsigned u32x4 __attribute__((ext_vector_type(4)));
typedef __bf16 bf16x2_t __attribute__((ext_vector_type(2)));

constexpr int DM = 1024, NB = 8, SEQ = 8192, CTX = 256, DFF = 2816;
constexpr int MLAT = NB * SEQ, MCTX = NB * CTX, MALL = MLAT + MCTX;
constexpr int INP = 2560;
constexpr int NWAVES = 8, NTHR = 512;
constexpr float LOG2E = 1.4426950408889634f;
constexpr float SC_A = 0.10206207261596575f * LOG2E;
constexpr float SC_B = 0.17677669529663687f * LOG2E;
constexpr float SC_C = 0.125f * LOG2E;
constexpr float SC_D = 0.125f * LOG2E;
constexpr int C_CQ = 0, C_CKV = 256, C_KR = 384, C_DQ = 416, C_DK = 672, C_DV = 928, C_NQ = 1184, C_NK = 1440, C_NV = 1696, C_GQ = 1952, C_GK = 2208, C_GV = 2336, C_END = 2464;

constexpr size_t MiB = 1u << 20;
constexpr size_t WS_MOD = 0;
constexpr size_t WS_TAB = 1 * MiB;
constexpr size_t WS_W = 2 * MiB, WL = 51 * MiB;
constexpr size_t W_GU1 = 0, W_DN1 = 11 * MiB, W_GU2 = 16 * MiB + MiB / 2, W_DN2 = 27 * MiB + MiB / 2, W_IN = 33 * MiB, W_MLA = 38 * MiB,
                 W_GATE = 38 * MiB + 3 * MiB / 4, W_BR = 46 * MiB + 3 * MiB / 4, W_OUT = 48 * MiB + 3 * MiB / 4;
constexpr size_t WS_HC = 104 * MiB;
constexpr size_t WS_U = 112 * MiB;
constexpr size_t WS_S = 244 * MiB;
constexpr size_t S_P = 0, S_R = 330 * MiB, S_DER = 462 * MiB;
constexpr size_t S_FFH = 0, S_Y = S_R, S_BR = 0, S_MG = S_DER;
constexpr size_t D_QA = 0, D_KA = (size_t)MALL * 768, D_VA = D_KA + (size_t)MALL * 768, D_QB = D_VA + (size_t)MALL * 512, D_KB = D_QB + (size_t)MALL * 512,
                 D_QD = D_KB + (size_t)MALL * 512, D_KD = D_QD + (size_t)MALL * 512;
constexpr size_t WS_END = WS_S + 726 * MiB;

DI float bf2f(bf16_t u) { return __uint_as_float((unsigned)u << 16); }
DI unsigned f2bf(float f) { unsigned u = __float_as_uint(f); return (u + 0x7fffu + ((u >> 16) & 1u)) >> 16; }
DI unsigned pk2(float lo, float hi) { f32x2 v = {lo, hi}; bf16x2_t b = __builtin_convertvector(v, bf16x2_t); return __builtin_bit_cast(unsigned, b); }
DI float wave_sum(float v) {
#pragma unroll
    for (int o = 1; o < 64; o <<= 1) v += __shfl_xor(v, o);
    return v;
}
DI int opaque_tid() { int t = threadIdx.x; asm volatile("" : "+v"(t)); return t; }
DI int opaque_bid() { int t = blockIdx.x; asm volatile("" : "+s"(t)); return t; }
DI float fast_exp2(float x) { return __builtin_amdgcn_exp2f(x); }
DI float fast_rcp(float x) { return __builtin_amdgcn_rcpf(x); }


constexpr int CTLO = 131072, CTL_EPI = CTLO + 256;
DI unsigned long long lds_u64(LAS unsigned char* lds, int off) { const volatile LAS unsigned* p = (const volatile LAS unsigned*)(lds + off);
    const unsigned lo = __builtin_amdgcn_readfirstlane(p[0]), hi = __builtin_amdgcn_readfirstlane(p[1]); return ((unsigned long long)hi << 32) | lo; }
DI unsigned lds_u32(LAS unsigned char* lds, int off) { const volatile LAS unsigned* p = (const volatile LAS unsigned*)(lds + off); return __builtin_amdgcn_readfirstlane(p[0]); }
#define INP_(k) ((const float*)lds_u64(lds, CTLO + 8 * (k)))
#define OUTP_ ((float*)lds_u64(lds, CTLO + 8 * 27))
#define WSP_ ((unsigned char*)lds_u64(lds, CTLO + 8 * 28))

namespace pg8 {
constexpr int BM = 256, BK = 64, HALF = 128, HTB = HALF * BK * 2, STAGE_BYTES = 8 * HTB, NXCD = 8, WGM = 8;
DI int lds_byte(int r, int c) { const int st = (r >> 4) * 2 + (c >> 5), rr = r & 15, cc = c & 31, ob = rr * 64 + cc * 2; return st * 1024 + (ob ^ (((ob >> 9) & 1) << 5)); }
DI void stage_rc(int b, int& R, int& C) { const int st = b / 1024, sb = b % 1024, swz = sb ^ (((sb >> 9) & 1) << 5); R = (st >> 1) * 16 + swz / 64; C = (st & 1) * 32 + (swz % 64) / 2; }
DI int perm32(int rho) { const int n = rho >> 4, i = rho & 15; return 8 * (i >> 2) + 4 * n + (i & 3); }
struct Unit { int pm, pn; };
struct Gemm { const bf16_t* A; const bf16_t* Bt; int M, N, K, lda; };
struct StaticOrder {
    int nM, nN, nwg, G, c;
    DI void init(int M, int N, int G_, int c_) { nM = M / BM; nN = N / BM; nwg = nM * nN; G = G_; c = c_; }
    DI bool next(int i, Unit& u) const {
        const long L = (long)i * G + c; if (L >= nwg) return false;
        int wgid = (int)L; { const int q = nwg / NXCD, r = nwg % NXCD, xcd = wgid % NXCD, off = wgid / NXCD; wgid = (xcd < r ? xcd * (q + 1) : r * (q + 1) + (xcd - r) * q) + off; }
        const int nig = WGM * nN, gid = wgid / nig, fm = gid * WGM, gsz = (nM - fm) < WGM ? (nM - fm) : WGM;
        u.pm = fm + ((wgid % nig) % gsz); u.pn = (wgid % nig) / gsz; return true;
    }
};

struct Epi {
    int mode; bool perm;
    bf16_t* O; int ldc;
    const float* base_lat; const float* base_ctx; float* out_lat; float* out_ctx; const float* modp; int gate_chunk; float gs;
    const float* bias; bf16_t* BR; bf16_t* MG; int gi;
    int row_off;
    DI void operator()(const f32x4 (&acc)[2][2][4][2], const Unit& u, int wr, int wc, int fr, int fq) const {
        const int row0 = row_off + u.pm * BM + wr * 64 + fr;
        if (mode == 0) {
            const int col0 = u.pn * BM + wc * 64 + 8 * fq;
#pragma unroll
            for (int ai = 0; ai < 2; ++ai)
#pragma unroll
                for (int m = 0; m < 4; ++m) { bf16_t* rowp = O + (size_t)(row0 + ai * HALF + m * 16) * ldc + col0;
#pragma unroll
                    for (int bj = 0; bj < 2; ++bj) { const f32x4 v0 = acc[ai][bj][m][0], v1 = acc[ai][bj][m][1];
                        u32x4 w; w.x = pk2(v0[0], v0[1]); w.y = pk2(v0[2], v0[3]); w.z = pk2(v1[0], v1[1]); w.w = pk2(v1[2], v1[3]);
                        *(GAS u32x4*)(rowp + bj * 32) = w; } }
        } else if (mode == 1) {
            const int col0 = u.pn * (BM / 2) + wc * 32 + 8 * fq;
#pragma unroll
            for (int ai = 0; ai < 2; ++ai)
#pragma unroll
                for (int m = 0; m < 4; ++m) { bf16_t* rowp = O + (size_t)(row0 + ai * HALF + m * 16) * ldc + col0; float o[8];
#pragma unroll
                    for (int n = 0; n < 2; ++n) { const f32x4 g = acc[ai][0][m][n], up = acc[ai][1][m][n];
#pragma unroll
                        for (int j = 0; j < 4; ++j) o[4 * n + j] = g[j] * fast_rcp(1.0f + fast_exp2(-g[j] * LOG2E)) * up[j]; }
                    u32x4 w; w.x = pk2(o[0], o[1]); w.y = pk2(o[2], o[3]); w.z = pk2(o[4], o[5]); w.w = pk2(o[6], o[7]);
                    *(GAS u32x4*)rowp = w; }
        } else if (mode == 2) {
            const int rowt = row_off + u.pm * BM; const bool lat = rowt < MLAT;
            const int vec = lat ? (rowt >> 13) : 8;
            const float* bp = lat ? base_lat : base_ctx - (size_t)MLAT * DM; float* op = lat ? out_lat : out_ctx - (size_t)MLAT * DM;
            const float* mrow = modp + (size_t)vec * 9216 + gate_chunk * 1024;
            const int col0 = u.pn * BM + wc * 64 + 4 * fq;
            f32x4 gv[2][2];
#pragma unroll
            for (int bj = 0; bj < 2; ++bj)
#pragma unroll
                for (int n = 0; n < 2; ++n) gv[bj][n] = *(const GAS f32x4*)(mrow + col0 + bj * 32 + n * 16) * gs;
#pragma unroll
            for (int ai = 0; ai < 2; ++ai)
#pragma unroll
                for (int m = 0; m < 4; ++m) { const size_t off = (size_t)(row0 + ai * HALF + m * 16) * DM + col0; f32x4 b[2][2];
#pragma unroll
                    for (int bj = 0; bj < 2; ++bj)
#pragma unroll
                        for (int n = 0; n < 2; ++n) b[bj][n] = *(const GAS f32x4*)(bp + off + bj * 32 + n * 16);
#pragma unroll
                    for (int bj = 0; bj < 2; ++bj)
#pragma unroll
                        for (int n = 0; n < 2; ++n) *(GAS f32x4*)(op + off + bj * 32 + n * 16) = b[bj][n] + gv[bj][n] * acc[ai][bj][m][n]; }
        } else {
            const int col0 = u.pn * BM + wc * 64 + 8 * fq;
            f32x4 bb[2][2];
#pragma unroll
            for (int bj = 0; bj < 2; ++bj) { bb[bj][0] = *(const GAS f32x4*)(bias + col0 + bj * 32); bb[bj][1] = *(const GAS f32x4*)(bias + col0 + bj * 32 + 4); }
#pragma unroll
            for (int ai = 0; ai < 2; ++ai)
#pragma unroll
                for (int m = 0; m < 4; ++m) { const size_t offb = (size_t)(row0 + ai * HALF + m * 16) * DM + col0;
                    u32x4 brv[2], mgv[2];
#pragma unroll
                    for (int bj = 0; bj < 2; ++bj) { brv[bj] = *(const GAS u32x4*)(BR + offb + bj * 32); mgv[bj] = (gi > 0) ? *(const GAS u32x4*)(MG + offb + bj * 32) : (u32x4){0, 0, 0, 0}; }
#pragma unroll
                    for (int bj = 0; bj < 2; ++bj) { const size_t off = offb + bj * 32; const u32x4 br = brv[bj], mg = mgv[bj];
                        f32x4 x0 = acc[ai][bj][m][0] + bb[bj][0], x1 = acc[ai][bj][m][1] + bb[bj][1]; float v[8];
                        const float bv[8] = {__uint_as_float(br.x << 16), __uint_as_float(br.x & 0xffff0000u), __uint_as_float(br.y << 16), __uint_as_float(br.y & 0xffff0000u),
                                             __uint_as_float(br.z << 16), __uint_as_float(br.z & 0xffff0000u), __uint_as_float(br.w << 16), __uint_as_float(br.w & 0xffff0000u)};
#pragma unroll
                        for (int j = 0; j < 4; ++j) { v[j] = fast_rcp(1.0f + fast_exp2(-x0[j] * LOG2E)) * bv[j]; v[4 + j] = fast_rcp(1.0f + fast_exp2(-x1[j] * LOG2E)) * bv[4 + j]; }
                        v[0] += __uint_as_float(mg.x << 16); v[1] += __uint_as_float(mg.x & 0xffff0000u); v[2] += __uint_as_float(mg.y << 16); v[3] += __uint_as_float(mg.y & 0xffff0000u);
                        v[4] += __uint_as_float(mg.z << 16); v[5] += __uint_as_float(mg.z & 0xffff0000u); v[6] += __uint_as_float(mg.w << 16); v[7] += __uint_as_float(mg.w & 0xffff0000u);
                        u32x4 w; w.x = pk2(v[0], v[1]); w.y = pk2(v[2], v[3]); w.z = pk2(v[4], v[5]); w.w = pk2(v[6], v[7]);
                        if (gi < 3) *(GAS u32x4*)(MG + off) = w; else *(GAS u32x4*)(BR + off) = w; } }
        }
    }
};

struct EpiL { unsigned mode, perm, ldc, gate_chunk, gi; float gs; unsigned long long O, base_lat, base_ctx, out_lat, out_ctx, modp, bias, BR, MG; unsigned row_off, pad_; };
DI void epi_store(LAS unsigned char* lds, const Epi& e) {
    volatile LAS EpiL* p = (volatile LAS EpiL*)(lds + CTL_EPI);
    p->mode = e.mode; p->perm = e.perm ? 1u : 0u; p->ldc = e.ldc; p->gate_chunk = e.gate_chunk; p->gi = e.gi; p->gs = e.gs;
    p->O = (unsigned long long)e.O; p->base_lat = (unsigned long long)e.base_lat; p->base_ctx = (unsigned long long)e.base_ctx; p->out_lat = (unsigned long long)e.out_lat;
    p->out_ctx = (unsigned long long)e.out_ctx; p->modp = (unsigned long long)e.modp; p->bias = (unsigned long long)e.bias; p->BR = (unsigned long long)e.BR; p->MG = (unsigned long long)e.MG; p->row_off = (unsigned)e.row_off;
}
DI Epi epi_load(LAS unsigned char* lds) {
    const volatile LAS u32x4* p4 = (const volatile LAS u32x4*)(lds + CTL_EPI);
    u32x4 q[7];
#pragma unroll
    for (int i = 0; i < 7; ++i) q[i] = p4[i];
    unsigned w[28];
#pragma unroll
    for (int i = 0; i < 7; ++i) { w[4 * i] = __builtin_amdgcn_readfirstlane(q[i].x); w[4 * i + 1] = __builtin_amdgcn_readfirstlane(q[i].y); w[4 * i + 2] = __builtin_amdgcn_readfirstlane(q[i].z); w[4 * i + 3] = __builtin_amdgcn_readfirstlane(q[i].w); }
#define W64(k) (((unsigned long long)w[(k) + 1] << 32) | w[k])
    Epi e;
    e.mode = (int)w[0]; e.perm = w[1] != 0u; e.ldc = (int)w[2]; e.gate_chunk = (int)w[3]; e.gi = (int)w[4]; e.gs = __uint_as_float(w[5]);
    e.O = (bf16_t*)W64(6); e.base_lat = (const float*)W64(8); e.base_ctx = (const float*)W64(10); e.out_lat = (float*)W64(12); e.out_ctx = (float*)W64(14);
    e.modp = (const float*)W64(16); e.bias = (const float*)W64(18); e.BR = (bf16_t*)W64(20); e.MG = (bf16_t*)W64(22); e.row_off = (int)w[24];
#undef W64
    return e;
}

DI void gemm_phase(LAS unsigned char* lds, const Gemm g, const StaticOrder& S, const bool eperm) {
    const int tid = opaque_tid(), wid = __builtin_amdgcn_readfirstlane(tid >> 6), lane = tid & 63, wr = wid >> 2, wc = wid & 3, fr = lane & 15, fq = lane >> 4;
    const int K = g.K, nt = K / BK, lda = g.lda;
    unsigned voffA[2], voffB[2];
#pragma unroll
    for (int i = 0; i < 2; ++i) { int R, C; stage_rc(tid * 16 + i * 8192, R, C); const int Rb = 64 * (R >> 5) + (eperm ? perm32(R & 31) : (R & 31));
        voffA[i] = (unsigned)(R * lda + C) * 2u; voffB[i] = (unsigned)(Rb * K + C) * 2u; }
    const size_t kstep = (size_t)(BK * 2);
    const size_t hstepA = (size_t)HALF * lda * 2, tstepA = 2 * hstepA, hstepB = (size_t)32 * K * 2, tstepB = (size_t)BM * K * 2;
    const unsigned ldsw = (unsigned)wid * 1024u;
    const int aoff = lds_byte(wr * 64 + fr, fq * 8), boff = lds_byte(wc * 32 + fr, fq * 8);
#define PG8_SA(b, h) (((b) * 2 + (h)) * HTB)
#define PG8_SB(b, h) ((4 + (b) * 2 + (h)) * HTB)
#define PG8_STAGE(bufoff, gbase, voff) do { _Pragma("unroll") for (int _i = 0; _i < 2; ++_i) \
        __builtin_amdgcn_global_load_lds((const unsigned*)((const char*)(gbase) + (voff)[_i]), (LAS unsigned*)(lds + (bufoff) + ldsw + _i * 8192), 16, 0, 0); } while (0)
#define PG8_LDA(dst, b, h) do { _Pragma("unroll") for (int m = 0; m < 4; ++m) _Pragma("unroll") for (int k = 0; k < 2; ++k) dst[m][k] = *(const LAS bf16x8*)(lds + PG8_SA(b, h) + aoff + m * 2048 + k * 1024); } while (0)
#define PG8_LDB(dst, b, h) do { _Pragma("unroll") for (int n = 0; n < 2; ++n) _Pragma("unroll") for (int k = 0; k < 2; ++k) dst[n][k] = *(const LAS bf16x8*)(lds + PG8_SB(b, h) + boff + n * 2048 + k * 1024); } while (0)
#define PG8_MMA(ai, bj, At, Bt) do { __builtin_amdgcn_s_setprio(1); _Pragma("unroll") for (int m = 0; m < 4; ++m) _Pragma("unroll") for (int n = 0; n < 2; ++n) _Pragma("unroll") for (int k = 0; k < 2; ++k) \
        acc[ai][bj][m][n] = __builtin_amdgcn_mfma_f32_16x16x32_bf16(Bt[n][k], At[m][k], acc[ai][bj][m][n], 0, 0, 0); __builtin_amdgcn_s_setprio(0); } while (0)
#define PG8_WAIT_V(n) asm volatile("s_waitcnt vmcnt(" #n ")" ::: "memory")
#define PG8_WAIT_L(n) asm volatile("s_waitcnt lgkmcnt(" #n ")" ::: "memory")
#define PG8_BAR __builtin_amdgcn_s_barrier()
#define PG8_SCHED __builtin_amdgcn_sched_barrier(0)
    Unit cur, nxt; int ui = 0;
    if (!S.next(0, cur)) return;
    f32x4 acc[2][2][4][2];
#pragma unroll
    for (int a = 0; a < 2; ++a)
#pragma unroll
        for (int b = 0; b < 2; ++b)
#pragma unroll
            for (int m = 0; m < 4; ++m)
#pragma unroll
                for (int n = 0; n < 2; ++n) acc[a][b][m][n] = (f32x4){0.f, 0.f, 0.f, 0.f};
    bf16x8 At[4][2], B0[2][2], B1[2][2];
    const char* cA = (const char*)g.A + (size_t)cur.pm * tstepA; const char* cB = (const char*)g.Bt + (size_t)cur.pn * tstepB;
    PG8_STAGE(PG8_SB(0, 0), cB, voffB); PG8_STAGE(PG8_SB(0, 1), cB + hstepB, voffB); PG8_STAGE(PG8_SA(0, 0), cA, voffA); PG8_STAGE(PG8_SA(0, 1), cA + hstepA, voffA);
    if (wr == 1) PG8_BAR;
    PG8_WAIT_V(2); PG8_BAR;
    PG8_STAGE(PG8_SB(1, 0), cB + kstep, voffB); PG8_STAGE(PG8_SA(1, 0), cA + kstep, voffA); PG8_STAGE(PG8_SB(1, 1), cB + hstepB + kstep, voffB);
    PG8_WAIT_V(6); PG8_BAR;
    for (;;) {
        const bool has_next = S.next(ui + 1, nxt);
        const char* nA = has_next ? (const char*)g.A + (size_t)nxt.pm * tstepA : cA; const char* nB = has_next ? (const char*)g.Bt + (size_t)nxt.pn * tstepB : cB;
        for (int t = 0; t < nt; t += 2) {
            const bool last = (t == nt - 2);
            const char* a1 = cA + (size_t)(t + 1) * kstep;
            const char* a2 = last ? nA : cA + (size_t)(t + 2) * kstep; const char* b2 = last ? nB : cB + (size_t)(t + 2) * kstep;
            const char* a3 = a2 + kstep; const char* b3 = b2 + kstep;
            PG8_LDB(B0, 0, 0); PG8_LDB(B1, 0, 1); PG8_SCHED; PG8_LDA(At, 0, 0); PG8_STAGE(PG8_SA(1, 1), a1 + hstepA, voffA);
            PG8_WAIT_V(8); PG8_WAIT_L(0); PG8_BAR; PG8_MMA(0, 0, At, B0); PG8_MMA(0, 1, At, B1); PG8_BAR; PG8_SCHED;
            PG8_LDA(At, 0, 1); PG8_STAGE(PG8_SB(0, 0), b2, voffB); PG8_STAGE(PG8_SB(0, 1), b2 + hstepB, voffB); PG8_STAGE(PG8_SA(0, 0), a2, voffA);
            PG8_WAIT_V(8); PG8_WAIT_L(0); PG8_BAR; PG8_MMA(1, 0, At, B0); PG8_MMA(1, 1, At, B1); PG8_BAR; PG8_SCHED;
            PG8_LDB(B0, 1, 0); PG8_LDB(B1, 1, 1); PG8_SCHED; PG8_LDA(At, 1, 0); PG8_STAGE(PG8_SA(0, 1), a2 + hstepA, voffA);
            PG8_WAIT_V(8); PG8_WAIT_L(0); PG8_BAR; PG8_MMA(0, 0, At, B0); PG8_MMA(0, 1, At, B1); PG8_BAR; PG8_SCHED;
            PG8_LDA(At, 1, 1); PG8_STAGE(PG8_SB(1, 0), b3, voffB); PG8_STAGE(PG8_SB(1, 1), b3 + hstepB, voffB); PG8_STAGE(PG8_SA(1, 0), a3, voffA);
            PG8_WAIT_V(8); PG8_WAIT_L(0); PG8_BAR; PG8_MMA(1, 0, At, B0); PG8_MMA(1, 1, At, B1); PG8_BAR; PG8_SCHED;
        }
        if (wr == 0) PG8_BAR;
        { const Epi E = epi_load(lds); E(acc, cur, wr, wc, fr, fq); }
        if (!has_next) break;
#pragma unroll
        for (int a = 0; a < 2; ++a)
#pragma unroll
            for (int b = 0; b < 2; ++b)
#pragma unroll
                for (int m = 0; m < 4; ++m)
#pragma unroll
                    for (int n = 0; n < 2; ++n) acc[a][b][m][n] = (f32x4){0.f, 0.f, 0.f, 0.f};
        cur = nxt; cA = nA; cB = nB; ++ui;
        if (wr == 1) PG8_BAR;
    }
    PG8_WAIT_V(0);
    PG8_BAR;
#undef PG8_SA
#undef PG8_SB
#undef PG8_STAGE
#undef PG8_LDA
#undef PG8_LDB
#undef PG8_MMA
#undef PG8_WAIT_V
#undef PG8_WAIT_L
#undef PG8_BAR
#undef PG8_SCHED
}
}

struct AttnU {
    const bf16_t* Q; const bf16_t* K; const bf16_t* V; bf16_t* Y;
    int qs, ks, vs, ys;
    int b, lt0, lt1;
    int q0;
    float m0, l0;
    const float* rpb;
    float lam, post; const float* subln;
};
DI int crow(int i, int h) { return (i & 3) + 8 * (i >> 2) + 4 * h; }

template <int DQK, int NMAP>
DI void att_qk(const LAS unsigned char* Kb, int r, int h, const bf16x8 (&qfm)[DQK / NMAP / 16], int mp, f32x16 (&S)[2]) {
    constexpr int DQM = DQK / NMAP, NKS = DQM / 16, KP = DQK * 2 + 16, CH = (NKS > 4) ? 3 : NKS;
    const LAS unsigned char* kp = Kb + r * KP + (mp * DQM + 8 * h) * 2;
    const f32x16 z = {0.f, 0.f, 0.f, 0.f, 0.f, 0.f, 0.f, 0.f, 0.f, 0.f, 0.f, 0.f, 0.f, 0.f, 0.f, 0.f};
#pragma unroll
    for (int c = 0; c < NKS / CH; ++c) {
        bf16x8 kf[2 * CH];
#pragma unroll
        for (int s = 0; s < CH; ++s) { kf[2 * s] = *(const LAS bf16x8*)(kp + 32 * (c * CH + s)); kf[2 * s + 1] = *(const LAS bf16x8*)(kp + 32 * KP + 32 * (c * CH + s)); }
        __builtin_amdgcn_sched_barrier(0);
        __builtin_amdgcn_s_setprio(1);
#pragma unroll
        for (int s = 0; s < CH; ++s) {
            if (c == 0 && s == 0) { S[0] = __builtin_amdgcn_mfma_f32_32x32x16_bf16(kf[0], qfm[0], z, 0, 0, 0); S[1] = __builtin_amdgcn_mfma_f32_32x32x16_bf16(kf[1], qfm[0], z, 0, 0, 0); }
            else { S[0] = __builtin_amdgcn_mfma_f32_32x32x16_bf16(kf[2 * s], qfm[c * CH + s], S[0], 0, 0, 0); S[1] = __builtin_amdgcn_mfma_f32_32x32x16_bf16(kf[2 * s + 1], qfm[c * CH + s], S[1], 0, 0, 0); }
        }
        __builtin_amdgcn_s_setprio(0);
        __builtin_amdgcn_sched_barrier(0);
    }
}
struct MaskP { int lt, qrow, qcol, rs, cs, qpos; const LAS float* rpbl; };
template <int MODE>
DI void att_sm_head(f32x16 (&S)[2], float& mrefm, float& lrunm, f32x16 (&om)[2], bool latent, const MaskP& mk, int h) {
    {
        f32x16& s0 = S[0]; f32x16& s1 = S[1];
        if (MODE == 1 && latent) {
            const LAS float* rl = mk.rpbl + (mk.lt - mk.qrow + 7) * 31 + (15 - mk.qcol);
#pragma unroll
            for (int i = 0; i < 16; ++i) { const int kc = crow(i, h);
                { const bool ok = (kc >= mk.cs) && (kc < mk.cs + 16); const float bz = rl[ok ? kc : mk.qcol]; s0[i] = ok ? s0[i] + bz : -1e30f; }
                { const int kc2 = kc + 32; const bool ok = (kc2 >= mk.cs) && (kc2 < mk.cs + 16); const float bz = rl[ok ? kc2 : mk.qcol]; s1[i] = ok ? s1[i] + bz : -1e30f; } }
        }
        if (MODE == 2 && latent) {
            const int kb = 64 * mk.lt;
#pragma unroll
            for (int i = 0; i < 16; ++i) { const int d0 = kb + crow(i, h) - mk.qpos, d1 = d0 + 32;
                if (d0 > 128 || d0 < -128) s0[i] = -1e30f; if (d1 > 128 || d1 < -128) s1[i] = -1e30f; }
        }
        float ma = fmaxf(fmaxf(s0[0], s0[1]), s0[2]), mb = fmaxf(fmaxf(s1[0], s1[1]), s1[2]);
#pragma unroll
        for (int i = 3; i < 15; i += 2) { ma = fmaxf(fmaxf(ma, s0[i]), s0[i + 1]); mb = fmaxf(fmaxf(mb, s1[i]), s1[i + 1]); }
        ma = fmaxf(fmaxf(ma, s0[15]), fmaxf(mb, s1[15]));
        { auto rr = __builtin_amdgcn_permlane32_swap(__float_as_uint(ma), __float_as_uint(ma), false, false); ma = fmaxf(__uint_as_float(rr[0]), __uint_as_float(rr[1])); }
        const bool uninit = mrefm < -1e29f;
        const bool need = uninit || (ma - mrefm > 8.0f);
        if (__any(need)) {
            const float mnew = need ? ma : mrefm;
            const float f = uninit ? 1.0f : fast_exp2(mrefm - mnew);
            mrefm = mnew; lrunm *= f;
#pragma unroll
            for (int e = 0; e < 2; ++e)
#pragma unroll
                for (int i = 0; i < 16; ++i) om[e][i] *= f;
        }
    }
}
DI void att_sm_tail(f32x16 (&S)[2], bf16x8 (&pkm)[2][2], const float mrefm, float& lrunm) {
    {
        f32x16& s0 = S[0]; f32x16& s1 = S[1];
        const f32x2 nm2 = {-mrefm, -mrefm};
        f32x2 acc2 = {0.f, 0.f};
#pragma unroll
        for (int i = 0; i < 16; i += 2) {
            f32x2 a = {s0[i], s0[i + 1]}, b = {s1[i], s1[i + 1]}; a += nm2; b += nm2;
            a.x = fast_exp2(a.x); a.y = fast_exp2(a.y); b.x = fast_exp2(b.x); b.y = fast_exp2(b.y);
            acc2 += a; acc2 += b; s0[i] = a.x; s0[i + 1] = a.y; s1[i] = b.x; s1[i + 1] = b.y;
        }
        lrunm += acc2.x + acc2.y;
#pragma unroll
        for (int s = 0; s < 2; ++s) {
            u32x4 w0, w1;
            w0.x = pk2(s0[8 * s + 0], s0[8 * s + 1]); w0.y = pk2(s0[8 * s + 2], s0[8 * s + 3]); w0.z = pk2(s0[8 * s + 4], s0[8 * s + 5]); w0.w = pk2(s0[8 * s + 6], s0[8 * s + 7]);
            w1.x = pk2(s1[8 * s + 0], s1[8 * s + 1]); w1.y = pk2(s1[8 * s + 2], s1[8 * s + 3]); w1.z = pk2(s1[8 * s + 4], s1[8 * s + 5]); w1.w = pk2(s1[8 * s + 6], s1[8 * s + 7]);
            pkm[0][s] = __builtin_bit_cast(bf16x8, w0); pkm[1][s] = __builtin_bit_cast(bf16x8, w1);
        }
    }
}
template <int MODE>
DI void att_sm(f32x16 (&S)[2], bf16x8 (&pkm)[2][2], float& mrefm, float& lrunm, f32x16 (&om)[2], bool latent, const MaskP& mk, int h) {
    att_sm_head<MODE>(S, mrefm, lrunm, om, latent, mk, h);
    att_sm_tail(S, pkm, mrefm, lrunm);
}
DI void att_pvmm1(const s16x4 (&lo)[4], const s16x4 (&hi)[4], const bf16x8 (&pkm)[2][2], f32x16& oe) {
#pragma unroll
    for (int q = 0; q < 4; ++q) { const bf16x8 vf = (bf16x8){lo[q][0], lo[q][1], lo[q][2], lo[q][3], hi[q][0], hi[q][1], hi[q][2], hi[q][3]};
        oe = __builtin_amdgcn_mfma_f32_32x32x16_bf16(vf, pkm[q >> 1][q & 1], oe, 0, 0, 0); }
}
DI void att_vload(const LAS unsigned char* vb, int e, s16x4 (&lo)[4], s16x4 (&hi)[4]) {
    constexpr int VP = 144;
#pragma unroll
    for (int q = 0; q < 4; ++q) { const LAS unsigned char* p = vb + (16 * q) * VP + 64 * e;
        lo[q] = __builtin_bit_cast(s16x4, __builtin_amdgcn_ds_read_tr16_b64_v4i16((LAS s16x4*)p));
        hi[q] = __builtin_bit_cast(s16x4, __builtin_amdgcn_ds_read_tr16_b64_v4i16((LAS s16x4*)(p + 8 * VP))); }
}
template <int NMAP>
DI void att_pvmm(const s16x4 (&lo)[4], const s16x4 (&hi)[4], const bf16x8 (&pk)[NMAP][2][2], f32x16 (&o)[NMAP][2], int e) {
    __builtin_amdgcn_s_setprio(1);
#pragma unroll
    for (int q = 0; q < 4; ++q) { const bf16x8 vf = (bf16x8){lo[q][0], lo[q][1], lo[q][2], lo[q][3], hi[q][0], hi[q][1], hi[q][2], hi[q][3]};
#pragma unroll
        for (int mp = 0; mp < NMAP; ++mp) o[mp][e] = __builtin_amdgcn_mfma_f32_32x32x16_bf16(vf, pk[mp][q >> 1][q & 1], o[mp][e], 0, 0, 0); }
    __builtin_amdgcn_s_setprio(0);
}
template <int NMAP>
DI void att_pv(const LAS unsigned char* vb, const bf16x8 (&pk)[NMAP][2][2], f32x16 (&o)[NMAP][2]) {
#pragma unroll
    for (int e = 0; e < 2; ++e) {
        s16x4 lo[4], hi[4];
        __builtin_amdgcn_sched_barrier(0);
        att_vload(vb, e, lo, hi);
        __builtin_amdgcn_sched_barrier(0);
        att_pvmm<NMAP>(lo, hi, pk, o, e);
    }
    __builtin_amdgcn_sched_barrier(0);
}


template <int DQK, int NMAP, int MODE>
DI void attn_unit(LAS unsigned char* lds, const AttnU& a) {
    constexpr int DQM = DQK / NMAP, NKS = DQM / 16;
    constexpr int KP = DQK * 2 + 16, VP = 144, KBUF = 64 * KP, VBUF = 64 * VP, CPR = DQK / 8;
    constexpr int OFF_V = 2 * KBUF, OFF_RPB = 2 * KBUF + 3 * VBUF;
    const int tid = opaque_tid(), lane = tid & 63, r = lane & 31, h = lane >> 5, wid = __builtin_amdgcn_readfirstlane(tid >> 6);
    const int nt = 4 + (a.lt1 - a.lt0);
    const int kr0 = tid / CPR, kc0 = tid % CPR; const int c1 = tid + NTHR; const bool has1 = (64 * CPR > NTHR) && (c1 < 64 * CPR); const int kr1 = c1 / CPR, kc1 = c1 % CPR;
    const int vr = tid >> 3, vc = tid & 7;
    u32x4 kq0[3], kq1[3], vq[3];
#pragma unroll
    for (int q = 0; q < 3; ++q) { kq0[q] = (u32x4){0, 0, 0, 0}; kq1[q] = (u32x4){0, 0, 0, 0}; vq[q] = (u32x4){0, 0, 0, 0}; }
#define TILE_ROW(j) ((j) < 4 ? (MLAT + a.b * CTX + 64 * (j)) : (a.b * SEQ + 64 * (a.lt0 + (j) - 4)))
#define ATT_LOAD(Q, j) do { const int jj_ = ((j) < nt) ? (j) : nt - 1; const size_t rb_ = (size_t)TILE_ROW(jj_); kq0[Q] = *(const GAS u32x4*)(a.K + (rb_ + kr0) * a.ks + kc0 * 8); \
        if (has1) kq1[Q] = *(const GAS u32x4*)(a.K + (rb_ + kr1) * a.ks + kc1 * 8); vq[Q] = *(const GAS u32x4*)(a.V + (rb_ + vr) * a.vs + vc * 8); } while (0)
#define ATT_STORE(Q, kslot, vslot) do { *(LAS u32x4*)(lds + (kslot) * KBUF + kr0 * KP + kc0 * 16) = kq0[Q]; if (has1) *(LAS u32x4*)(lds + (kslot) * KBUF + kr1 * KP + kc1 * 16) = kq1[Q]; \
        *(LAS u32x4*)(lds + OFF_V + (vslot) * VBUF + vr * VP + vc * 16) = vq[Q]; } while (0)
    ATT_LOAD(0, 0); ATT_LOAD(1, 1); ATT_LOAD(2, 2);
    if (MODE == 1) { LAS float* rl = (LAS float*)(lds + OFF_RPB); for (int i = tid; i < 465; i += NTHR) rl[i] = ((const GAS float*)a.rpb)[i] * LOG2E; }
    bf16x8 qf[NMAP][NKS];
    { const bf16_t* qp = a.Q + (size_t)(32 * wid + r) * a.qs + 8 * h;
#pragma unroll
      for (int mp = 0; mp < NMAP; ++mp)
#pragma unroll
          for (int s = 0; s < NKS; ++s) qf[mp][s] = *(const GAS bf16x8*)(qp + mp * DQM + 16 * s); }
    float mref[NMAP], lrun[NMAP]; f32x16 o[NMAP][2];
#pragma unroll
    for (int mp = 0; mp < NMAP; ++mp) { mref[mp] = a.m0; lrun[mp] = (h == 0) ? a.l0 : 0.f;
#pragma unroll
        for (int e = 0; e < 2; ++e)
#pragma unroll
            for (int i = 0; i < 16; ++i) o[mp][e][i] = 0.f; }
    const int qw0 = a.q0 + 32 * wid;
    MaskP mk; mk.qrow = qw0 >> 6; mk.qcol = (qw0 & 63) + r; mk.qpos = qw0 + r; mk.rpbl = (const LAS float*)(lds + OFF_RPB); mk.lt = 0;
    { int rs = mk.qrow - 4; mk.rs = rs < 0 ? 0 : (rs > 120 ? 120 : rs); int cs = mk.qcol - 8; mk.cs = cs < 0 ? 0 : (cs > 48 ? 48 : cs); }
#define ATT_ACTIVE(j) ((j) < 4 ? true : (MODE == 1 ? ((a.lt0 + (j) - 4 >= mk.rs) && (a.lt0 + (j) - 4 < mk.rs + 8)) : (MODE == 2 ? ((64 * (a.lt0 + (j) - 4) + 63 >= qw0 - 128) && (64 * (a.lt0 + (j) - 4) <= qw0 + 31 + 128)) : true)))
    const LAS unsigned char* vlane = lds + OFF_V + (4 * h + ((lane & 15) >> 2)) * VP + ((lane >> 4) & 1) * 32 + (lane & 3) * 8;
    f32x16 S[2]; bf16x8 pk[NMAP][2][2];
    ATT_STORE(0, 0, 0);
    __syncthreads();
#define ATT_BODY_A(IT, P) { ATT_LOAD(P, (IT) + 3); \
        if ((IT) < nt && ATT_ACTIVE(IT)) { mk.lt = a.lt0 + (IT) - 4; \
            if (NMAP == 1) { s16x4 lo_[4], hi_[4]; \
                att_qk<DQK, NMAP>(lds + ((IT) & 1) * KBUF, r, h, qf[0], 0, S); __builtin_amdgcn_sched_barrier(0); \
                att_vload(vlane + (P) * VBUF, 0, lo_, hi_); __builtin_amdgcn_sched_barrier(0);       \
                att_sm<MODE>(S, pk[0], mref[0], lrun[0], o[0], (IT) >= 4, mk, h); __builtin_amdgcn_sched_barrier(0); \
                att_pvmm<NMAP>(lo_, hi_, pk, o, 0); __builtin_amdgcn_sched_barrier(0); \
                att_vload(vlane + (P) * VBUF, 1, lo_, hi_); __builtin_amdgcn_sched_barrier(0); \
                att_pvmm<NMAP>(lo_, hi_, pk, o, 1); __builtin_amdgcn_sched_barrier(0); \
            } else { s16x4 lo_[4], hi_[4]; \
                att_qk<DQK, NMAP>(lds + ((IT) & 1) * KBUF, r, h, qf[0], 0, S); __builtin_amdgcn_sched_barrier(0); \
                att_sm<MODE>(S, pk[0], mref[0], lrun[0], o[0], (IT) >= 4, mk, h); __builtin_amdgcn_sched_barrier(0); \
                att_qk<DQK, NMAP>(lds + ((IT) & 1) * KBUF, r, h, qf[NMAP - 1], NMAP - 1, S); __builtin_amdgcn_sched_barrier(0); \
                att_vload(vlane + (P) * VBUF, 0, lo_, hi_); __builtin_amdgcn_sched_barrier(0); \
                att_sm_head<MODE>(S, mref[NMAP - 1], lrun[NMAP - 1], o[NMAP - 1], (IT) >= 4, mk, h); __builtin_amdgcn_sched_barrier(0); \
                  \
                att_pvmm1(lo_, hi_, pk[0], o[0][0]); att_sm_tail(S, pk[NMAP - 1], mref[NMAP - 1], lrun[NMAP - 1]); \
                __builtin_amdgcn_sched_group_barrier(0x8, 1, 0); __builtin_amdgcn_sched_group_barrier(0x2, 20, 0); \
                __builtin_amdgcn_sched_group_barrier(0x8, 1, 0); __builtin_amdgcn_sched_group_barrier(0x2, 20, 0); \
                __builtin_amdgcn_sched_group_barrier(0x8, 1, 0); __builtin_amdgcn_sched_group_barrier(0x2, 20, 0); \
                __builtin_amdgcn_sched_group_barrier(0x8, 1, 0); __builtin_amdgcn_sched_group_barrier(0x2, 20, 0); \
                __builtin_amdgcn_sched_barrier(0); \
                att_pvmm1(lo_, hi_, pk[NMAP - 1], o[NMAP - 1][0]); __builtin_amdgcn_sched_barrier(0); \
                att_vload(vlane + (P) * VBUF, 1, lo_, hi_); __builtin_amdgcn_sched_barrier(0); \
                att_pvmm<NMAP>(lo_, hi_, pk, o, 1); __builtin_amdgcn_sched_barrier(0); } } \
        ATT_STORE(((P) + 1) % 3, ((IT) + 1) & 1, ((P) + 1) % 3); __syncthreads(); }
    __builtin_amdgcn_s_waitcnt(0x0F70);
    const int nt3 = ((nt + 2) / 3) * 3;
    for (int it = 0; it < nt3; it += 3) {
        ATT_BODY_A(it, 0);
        ATT_BODY_A(it + 1, 1);
        ATT_BODY_A(it + 2, 2);
    }
#undef ATT_BODY_A
#undef TILE_ROW
#undef ATT_LOAD
#undef ATT_STORE
#undef ATT_ACTIVE
    float inv[NMAP];
#pragma unroll
    for (int mp = 0; mp < NMAP; ++mp) { const float lt_ = lrun[mp] + __shfl_xor(lrun[mp], 32); inv[mp] = 1.0f / lt_; }
    f32x16 y[2];
    if (NMAP == 1) {
#pragma unroll
        for (int e = 0; e < 2; ++e)
#pragma unroll
            for (int i = 0; i < 16; ++i) y[e][i] = o[0][e][i] * inv[0];
    } else {
        float ss = 0.f; const float li = a.lam * inv[NMAP - 1];
#pragma unroll
        for (int e = 0; e < 2; ++e)
#pragma unroll
            for (int i = 0; i < 16; ++i) { const float v = o[0][e][i] * inv[0] - li * o[NMAP - 1][e][i]; y[e][i] = v; ss += v * v; }
        ss += __shfl_xor(ss, 32);
        const float rstd = rsqrtf(ss * (1.0f / 64.0f) + 1e-5f) * a.post;
#pragma unroll
        for (int e = 0; e < 2; ++e)
#pragma unroll
            for (int g4 = 0; g4 < 4; ++g4) { const f32x4 sg = *(const GAS f32x4*)(a.subln + 32 * e + 8 * g4 + 4 * h);
#pragma unroll
                for (int jj = 0; jj < 4; ++jj) y[e][4 * g4 + jj] *= rstd * sg[jj]; }
    }
    bf16_t* yp = a.Y + (size_t)(32 * wid + r) * a.ys + 8 * h;
#pragma unroll
    for (int e = 0; e < 2; ++e)
#pragma unroll
        for (int t = 0; t < 2; ++t) {
            const unsigned a0 = pk2(y[e][8 * t], y[e][8 * t + 1]), a1 = pk2(y[e][8 * t + 2], y[e][8 * t + 3]);
            const unsigned b0 = pk2(y[e][8 * t + 4], y[e][8 * t + 5]), b1 = pk2(y[e][8 * t + 6], y[e][8 * t + 7]);
            const auto r0 = __builtin_amdgcn_permlane32_swap(a0, b0, false, false), r1 = __builtin_amdgcn_permlane32_swap(a1, b1, false, false);
            u32x4 w; w.x = r0[0]; w.y = r1[0]; w.z = r0[1]; w.w = r1[1];
            *(GAS u32x4*)(yp + 32 * e + 16 * t) = w; }
}

struct Params { const float* in[27]; float* out; unsigned char* ws; };

struct ConvJob { const float* src; int K, N; bf16_t* dst; int ldd, koff, rowoff, mode; const float* kgain; int sn0, sn1; float scale; };
DI void conv_item(const ConvJob& J, LAS float* scr, int item, int lane) {
    const int nblk = J.N / 32, kb = item / nblk, nb = item % nblk, k0 = 64 * kb, n0 = 32 * nb;
    { float tv[32];
#pragma unroll
      for (int i = 0; i < 32; ++i) tv[i] = ((const GAS float*)J.src)[(size_t)(k0 + 2 * i + (lane >> 5)) * J.N + n0 + (lane & 31)];
#pragma unroll
      for (int i = 0; i < 32; ++i) scr[(2 * i + (lane >> 5)) * 33 + (lane & 31)] = tv[i]; }
    asm volatile("s_waitcnt lgkmcnt(0)" ::: "memory");
    const int c = lane & 7;
    float gk[8];
#pragma unroll
    for (int q = 0; q < 8; ++q) gk[q] = J.kgain ? J.kgain[k0 + 8 * c + q] : 1.0f;
#pragma unroll
    for (int j = 0; j < 4; ++j) { const int nl = (lane >> 3) + 8 * j, n = n0 + nl; const LAS float* s = scr + (8 * c) * 33 + nl;
        const float sc = (n >= J.sn0 && n < J.sn1) ? J.scale : 1.0f;
        int row = n;
        if (J.mode == 1) { const int hu = (n < DFF) ? n : n - DFF; row = 256 * (hu >> 7) + 64 * ((hu >> 5) & 3) + (hu & 31) + ((n < DFF) ? 0 : 32); }
        u32x4 o; o.x = pk2(s[0 * 33] * gk[0] * sc, s[1 * 33] * gk[1] * sc); o.y = pk2(s[2 * 33] * gk[2] * sc, s[3 * 33] * gk[3] * sc);
        o.z = pk2(s[4 * 33] * gk[4] * sc, s[5 * 33] * gk[5] * sc); o.w = pk2(s[6 * 33] * gk[6] * sc, s[7 * 33] * gk[7] * sc);
        *(u32x4*)(J.dst + (size_t)(J.rowoff + row) * J.ldd + J.koff + k0 + 8 * c) = o; }
    asm volatile("s_waitcnt lgkmcnt(0)" ::: "memory");
}

DI bool get_conv_job(LAS unsigned char* lds, int l, int j, ConvJob& J) {
    unsigned char* wl = WSP_ + WS_W + (size_t)l * WL;
    J.kgain = nullptr; J.sn0 = 0; J.sn1 = 0; J.scale = 1.f; J.koff = 0; J.rowoff = 0; J.mode = 0;
    switch (j) {
    case 0: J.src = INP_(7) + (size_t)l * DM * 2 * DFF; J.K = DM; J.N = 2 * DFF; J.dst = (bf16_t*)(wl + W_GU1); J.ldd = DM; J.mode = 1; return true;
    case 1: J.src = INP_(8) + (size_t)l * DFF * DM; J.K = DFF; J.N = DM; J.dst = (bf16_t*)(wl + W_DN1); J.ldd = DFF; return true;
    case 2: J.src = INP_(24) + (size_t)l * DM * 2 * DFF; J.K = DM; J.N = 2 * DFF; J.dst = (bf16_t*)(wl + W_GU2); J.ldd = DM; J.mode = 1; return true;
    case 3: J.src = INP_(25) + (size_t)l * DFF * DM; J.K = DFF; J.N = DM; J.dst = (bf16_t*)(wl + W_DN2); J.ldd = DFF; return true;
    case 4: J.src = INP_(10) + (size_t)l * DM * C_END; J.K = DM; J.N = C_END; J.dst = (bf16_t*)(wl + W_IN); J.ldd = DM; J.sn0 = C_NQ; J.sn1 = C_NK; J.scale = SC_C; return true;
    case 5: J.src = INP_(12) + (size_t)l * 256 * 384; J.K = 256; J.N = 384; J.dst = (bf16_t*)(wl + W_MLA); J.ldd = 384; J.kgain = INP_(11) + l * 256; return true;
    case 6: J.src = INP_(14) + (size_t)l * 128 * 512; J.K = 128; J.N = 512; J.dst = (bf16_t*)(wl + W_MLA); J.ldd = 384; J.koff = 256; J.rowoff = 384; J.kgain = INP_(13) + l * 128; return true;
    case 7: case 8: case 9: case 10: { const int i = j - 7; J.src = INP_(20) + ((size_t)l * 4 + i) * DM * DM; J.K = DM; J.N = DM; J.dst = (bf16_t*)(wl + W_GATE) + (size_t)i * DM * DM; J.ldd = DM; return true; }
    case 11: case 12: case 13: case 14: { const int i = j - 11; J.src = INP_(19) + ((size_t)l * 4 + i) * 256 * DM; J.K = 256; J.N = DM; J.dst = (bf16_t*)(wl + W_BR) + (size_t)i * DM * 256; J.ldd = 256; return true; }
    case 15: J.src = INP_(22) + (size_t)l * DM * DM; J.K = DM; J.N = DM; J.dst = (bf16_t*)(wl + W_OUT); J.ldd = DM; return true;
    default: return false;
    }
}

DI void prologue_phase(LAS unsigned char* lds, int G) {
    const int tid = opaque_tid(), lane = tid & 63, wave = tid >> 6, bid = opaque_bid();
    const int gw = bid * NWAVES + wave, NGW = G * NWAVES;
    LAS float* stab = (LAS float*)lds;
    unsigned char* const ws = WSP_; const float* const cin = INP_(1); const float* const ccin = INP_(3); const float* const wada = INP_(4); const float* const bada = INP_(5);
    for (int i = tid; i < 9 * DM; i += NTHR) { const float v = (i < 8 * DM) ? cin[i] : ccin[i - 8 * DM]; stab[i] = v * fast_rcp(1.0f + __expf(-v)); }
    __syncthreads();
    { float* MOD = (float*)(ws + WS_MOD); const int kq = lane >> 4, cc = lane & 15;
      for (int it = gw; it < 2 * 576; it += NGW) { const int l = it / 576, col = (it % 576) * 16 + cc;
          const float* w = wada + (size_t)l * DM * 9216 + col; float acc[9];
#pragma unroll
          for (int v = 0; v < 9; ++v) acc[v] = 0.f;
#pragma unroll 8
          for (int k = kq; k < DM; k += 4) { const float wv = w[(size_t)k * 9216];
#pragma unroll
              for (int v = 0; v < 9; ++v) acc[v] += stab[v * DM + k] * wv; }
#pragma unroll
          for (int v = 0; v < 9; ++v) { acc[v] += __shfl_xor(acc[v], 16); acc[v] += __shfl_xor(acc[v], 32); }
          if (kq == 0) { const float bb = bada[l * 9216 + col];
#pragma unroll
              for (int v = 0; v < 9; ++v) MOD[((size_t)l * 9 + v) * 9216 + col] = acc[v] + bb; } } }
    __syncthreads();
    { float* T32 = (float*)(ws + WS_TAB); float* T64 = T32 + 128 * 8 * 2; float* SCL = T64 + 128 * 16 * 2;
      const int gt = bid * NTHR + tid;
      if (gt < 128 * 8) { const int pos = gt >> 3, i = gt & 7; float t = (float)pos * (exp2f(-(float)i * (13.287712379549449f / 8.0f)) * 0.15915494309189535f); t -= rintf(t);
          T32[2 * gt] = __builtin_amdgcn_cosf(t); T32[2 * gt + 1] = __builtin_amdgcn_sinf(t); }
      else if (gt < 128 * 8 + 128 * 16) { const int g2 = gt - 128 * 8, pos = g2 >> 4, i = g2 & 15; float t = (float)pos * (exp2f(-(float)i * (13.287712379549449f / 16.0f)) * 0.15915494309189535f); t -= rintf(t);
          T64[2 * g2] = __builtin_amdgcn_cosf(t); T64[2 * g2 + 1] = __builtin_amdgcn_sinf(t); }
      else if (gt < 128 * 24 + 2) { const int l = gt - 128 * 24; const float* dl = INP_(15) + l * 128; float a0 = 0.f, a1 = 0.f;
          for (int i = 0; i < 32; ++i) { a0 += dl[i] * dl[32 + i]; a1 += dl[64 + i] * dl[96 + i]; }
          const float lam_init = 0.8f - 0.6f * __expf(-0.3f * (float)l);
          SCL[2 * l] = __expf(a0) - __expf(a1) + lam_init; SCL[2 * l + 1] = 1.0f - lam_init; } }
    for (int l = 0; l < 2; ++l) { unsigned char* wl = ws + WS_W + (size_t)l * WL;
        u32x4* zin = (u32x4*)(wl + W_IN + (size_t)C_END * DM * 2); const int nzin = (INP - C_END) * DM * 2 / 16;
        for (int i = bid * NTHR + tid; i < nzin; i += G * NTHR) zin[i] = (u32x4){0, 0, 0, 0};
        bf16_t* wm = (bf16_t*)(wl + W_MLA);
        for (int i = bid * NTHR + tid; i < 1024 * 384 / 8; i += G * NTHR) { const int row = i / 48, k8 = (i % 48) * 8;
            const bool z = (row < 384) ? (k8 >= 256) : (row < 896 ? (k8 < 256) : true);
            if (z) *(u32x4*)(wm + (size_t)row * 384 + k8) = (u32x4){0, 0, 0, 0}; } }
    { LAS float* scr = (LAS float*)(lds + wave * 16384); int rot = 0;
      for (int j = 0; j < 16; ++j) { ConvJob J; get_conv_job(lds, 0, j, J); const int nit = (J.K / 64) * (J.N / 32);
          int start = gw - rot; start %= NGW; if (start < 0) start += NGW;
          for (int it = start; it < nit; it += NGW) conv_item(J, scr, it, lane);
          rot = (rot + nit) % NGW; } }
}
DI void conv_tail_fill(LAS unsigned char* lds, int G) {
    const int tid = opaque_tid(), lane = tid & 63, wave = tid >> 6, bid = opaque_bid();
    const int nskip = (G > 64) ? 32 : 0;
    if (bid < nskip) return;
    const int gw = (bid - nskip) * NWAVES + wave, NGW = (G - nskip) * NWAVES;
    LAS float* scr = (LAS float*)(lds + wave * 16384); int rot = 0;
    for (int j = 0; j < 16; ++j) { ConvJob J; get_conv_job(lds, 1, j, J); const int nit = (J.K / 64) * (J.N / 32);
        int start = gw - rot; start %= NGW; if (start < 0) start += NGW;
        for (int it = start; it < nit; it += NGW) conv_item(J, scr, it, lane);
        rot = (rot + nit) % NGW; }
}

DI void nm_phase(const float* src_lat, const float* src_ctx, const float* gain, const float* modl, int ch_shift, int ch_scale, bf16_t* U, int M, int G, int row_lo = 0, int wg_lo = 0) {
    const int tid_ = opaque_tid(), lane = tid_ & 63, wave = tid_ >> 6, bid_ = opaque_bid();
    if (bid_ < wg_lo) return;
    const int gw = (bid_ - wg_lo) * NWAVES + wave, NGW = (G - wg_lo) * NWAVES;
    f32x4 gv[4];
#pragma unroll
    for (int j = 0; j < 4; ++j) gv[j] = *((const GAS f32x4*)gain + lane + 64 * j);
    for (int row0 = row_lo + gw; row0 < M; row0 += 2 * NGW) {
        const int row1 = row0 + NGW; const bool two = row1 < M;
        const float* xr0 = (row0 < MLAT) ? src_lat + (size_t)row0 * DM : src_ctx + (size_t)(row0 - MLAT) * DM;
        const float* xr1 = two ? ((row1 < MLAT) ? src_lat + (size_t)row1 * DM : src_ctx + (size_t)(row1 - MLAT) * DM) : xr0;
        f32x4 v0[4], v1[4]; float s0 = 0.f, s1 = 0.f;
#pragma unroll
        for (int j = 0; j < 4; ++j) { v0[j] = __builtin_nontemporal_load((const GAS f32x4*)xr0 + lane + 64 * j); v1[j] = __builtin_nontemporal_load((const GAS f32x4*)xr1 + lane + 64 * j); }
#pragma unroll
        for (int j = 0; j < 4; ++j) { s0 += (v0[j].x * v0[j].x + v0[j].y * v0[j].y) + (v0[j].z * v0[j].z + v0[j].w * v0[j].w); s1 += (v1[j].x * v1[j].x + v1[j].y * v1[j].y) + (v1[j].z * v1[j].z + v1[j].w * v1[j].w); }
        const float rstd0 = rsqrtf(wave_sum(s0) * (1.0f / DM) + 1e-6f), rstd1 = rsqrtf(wave_sum(s1) * (1.0f / DM) + 1e-6f);
        const int vec0 = (row0 < MLAT) ? (row0 >> 13) : 8, vec1 = two ? ((row1 < MLAT) ? (row1 >> 13) : 8) : vec0;
        const float* mv0 = modl + (size_t)vec0 * 9216; const float* mv1 = modl + (size_t)vec1 * 9216;
        f32x4 sh0[4], sc0[4], sh1[4], sc1[4];
#pragma unroll
        for (int j = 0; j < 4; ++j) { sh0[j] = *((const GAS f32x4*)(mv0 + ch_shift * 1024) + lane + 64 * j); sc0[j] = *((const GAS f32x4*)(mv0 + ch_scale * 1024) + lane + 64 * j);
            sh1[j] = *((const GAS f32x4*)(mv1 + ch_shift * 1024) + lane + 64 * j); sc1[j] = *((const GAS f32x4*)(mv1 + ch_scale * 1024) + lane + 64 * j); }
        { bf16_t* ur = U + (size_t)row0 * DM;
#pragma unroll
          for (int j = 0; j < 4; ++j) { const f32x4 o = v0[j] * rstd0 * gv[j] * (sc0[j] + 1.0f) + sh0[j]; u32x2 w; w.x = pk2(o.x, o.y); w.y = pk2(o.z, o.w); *((GAS u32x2*)ur + lane + 64 * j) = w; } }
        if (two) { bf16_t* ur = U + (size_t)row1 * DM;
#pragma unroll
          for (int j = 0; j < 4; ++j) { const f32x4 o = v1[j] * rstd1 * gv[j] * (sc1[j] + 1.0f) + sh1[j]; u32x2 w; w.x = pk2(o.x, o.y); w.y = pk2(o.z, o.w); *((GAS u32x2*)ur + lane + 64 * j) = w; } }
    }
}

DI void final_phase(float* H, const float* gain, int G) {
    const int tid_ = opaque_tid(), lane = tid_ & 63, wave = tid_ >> 6, gw = opaque_bid() * NWAVES + wave, NGW = G * NWAVES;
    f32x4 gv[4];
#pragma unroll
    for (int j = 0; j < 4; ++j) gv[j] = *((const GAS f32x4*)gain + lane + 64 * j);
    for (int row = gw; row < MLAT; row += NGW) { float* xr = H + (size_t)row * DM; f32x4 v[4]; float s = 0.f;
#pragma unroll
        for (int j = 0; j < 4; ++j) { v[j] = *((const GAS f32x4*)xr + lane + 64 * j); s += (v[j].x * v[j].x + v[j].y * v[j].y) + (v[j].z * v[j].z + v[j].w * v[j].w); }
        const float rstd = rsqrtf(wave_sum(s) * (1.0f / DM) + 1e-6f);
#pragma unroll
        for (int j = 0; j < 4; ++j) *((GAS f32x4*)xr + lane + 64 * j) = v[j] * rstd * gv[j]; }
}

DI void unpack8(const u32x4 w, float (&x)[8]) {
    x[0] = __uint_as_float(w.x << 16); x[1] = __uint_as_float(w.x & 0xffff0000u); x[2] = __uint_as_float(w.y << 16); x[3] = __uint_as_float(w.y & 0xffff0000u);
    x[4] = __uint_as_float(w.z << 16); x[5] = __uint_as_float(w.z & 0xffff0000u); x[6] = __uint_as_float(w.w << 16); x[7] = __uint_as_float(w.w & 0xffff0000u);
}
DI u32x4 pack8(const float (&x)[8]) { u32x4 w; w.x = pk2(x[0], x[1]); w.y = pk2(x[2], x[3]); w.z = pk2(x[4], x[5]); w.w = pk2(x[6], x[7]); return w; }
DI u32x4 rope_math(const u32x4 xw, const u32x4 pw, const f32x4 (&tb)[4], float sgn, float scale) {
    float x[8], xp[8], o[8]; unpack8(xw, x); unpack8(pw, xp);
#pragma unroll
    for (int q = 0; q < 4; ++q) { const f32x4 cs = tb[q];
        o[2 * q] = (x[2 * q] * cs[0] + sgn * xp[2 * q] * cs[1]) * scale; o[2 * q + 1] = (x[2 * q + 1] * cs[2] + sgn * xp[2 * q + 1] * cs[3]) * scale; }
    return pack8(o);
}
DI void derive_phase(LAS unsigned char* lds, int G) {
    const int tid_ = opaque_tid(), lane = tid_ & 63, wave = tid_ >> 6, gw = opaque_bid() * NWAVES + wave, NGW = G * NWAVES;
    unsigned char* const ws = WSP_;
    const GAS bf16_t* PB = (const GAS bf16_t*)(ws + WS_S + S_P); const GAS bf16_t* RB = (const GAS bf16_t*)(ws + WS_S + S_R);
    unsigned char* der = ws + WS_S + S_DER;
    GAS bf16_t *QA = (GAS bf16_t*)(der + D_QA), *KA = (GAS bf16_t*)(der + D_KA), *VA = (GAS bf16_t*)(der + D_VA), *QB = (GAS bf16_t*)(der + D_QB), *KB = (GAS bf16_t*)(der + D_KB), *QD = (GAS bf16_t*)(der + D_QD), *KD = (GAS bf16_t*)(der + D_KD);
    const GAS float* T32 = (const GAS float*)(ws + WS_TAB); const GAS float* T64 = T32 + 128 * 8 * 2;
    const int hh = (lane >> 3) & 3, cc = lane & 7;
    const bool q1 = lane < 32;
    const int c3 = lane & 31, e3 = (8 * c3) & 31;
    const bool q4 = (lane & 31) < 16; const int h4 = (lane >> 2) & 3, c4 = lane & 3, e4 = 8 * c4;
    const int c5 = q1 ? lane : lane - 32, e5 = (8 * c5) & 63;
    for (int row = gw; row < MALL; row += NGW) {
        const bool lat = row < MLAT; const int t = row & (SEQ - 1); const int prow = lat ? (t >> 6) : 0, pcol = lat ? (t & 63) : 0;
        const GAS bf16_t* p = PB + (size_t)row * INP; const GAS bf16_t* rr = RB + (size_t)row * DM;
        const u32x4 w0 = *(const GAS u32x4*)(p + (lane < 32 ? C_CQ + lane * 8 : C_CKV + ((lane - 32) & 15) * 8));
        const u32x4 a1 = *(const GAS u32x4*)(q1 ? rr + hh * 96 + cc * 8 : rr + 384 + hh * 128 + cc * 8);
        const u32x4 a2 = *(const GAS u32x4*)(rr + 384 + hh * 128 + 64 + cc * 8);
        const GAS bf16_t* b3 = p + (q1 ? C_DQ : C_DK);
        const u32x4 x3 = *(const GAS u32x4*)(b3 + 8 * c3), p3 = *(const GAS u32x4*)(b3 + 8 * (c3 ^ 1));
        const GAS bf16_t* b4 = q4 ? rr + h4 * 96 + 64 : p + C_KR;
        const u32x4 x4 = *(const GAS u32x4*)(b4 + 8 * c4), p4 = *(const GAS u32x4*)(b4 + 8 * (c4 ^ 1));
        const GAS bf16_t* b5 = p + (q1 ? C_GQ : C_GK);
        const u32x4 x5 = *(const GAS u32x4*)(b5 + 8 * c5), p5 = *(const GAS u32x4*)(b5 + 8 * (c5 ^ 2));
        f32x4 t3[4], t4[4], t5[4];
        { const GAS f32x4* a = (const GAS f32x4*)(T32 + (((e3 & 16) ? pcol : prow)) * 16); const GAS f32x4* b = (const GAS f32x4*)(T32 + (((e4 & 16) ? pcol : prow)) * 16);
          const GAS f32x4* c = (const GAS f32x4*)(T64 + ((((e5 & 32) ? pcol : prow)) * 16 + (e5 & 8)) * 2);
#pragma unroll
          for (int q = 0; q < 4; ++q) { t3[q] = a[q]; t4[q] = b[q]; t5[q] = c[q]; } }
        float sq = 0.f, skv = 0.f;
        { float x[8]; unpack8(w0, x); float a = 0.f;
#pragma unroll
          for (int q = 0; q < 8; ++q) a += x[q] * x[q];
          if (lane < 32) sq = a; else if (lane < 48) skv = a; }
        const float rq = rsqrtf(wave_sum(sq) * (1.0f / 256.0f) + 1e-6f), rkv = rsqrtf(wave_sum(skv) * (1.0f / 128.0f) + 1e-6f);
        { const float sc = q1 ? rq * SC_A : rkv; float x[8]; unpack8(a1, x);
#pragma unroll
          for (int q = 0; q < 8; ++q) x[q] *= sc;
          *(GAS u32x4*)((q1 ? QA : KA) + (size_t)row * 384 + hh * 96 + cc * 8) = pack8(x); }
        if (lane < 32) { float x[8]; unpack8(a2, x);
#pragma unroll
            for (int q = 0; q < 8; ++q) x[q] *= rkv;
            *(GAS u32x4*)(VA + (size_t)row * 256 + lane * 8) = pack8(x); }
        *(GAS u32x4*)((q1 ? QB : KB) + (size_t)row * 256 + 8 * c3) = rope_math(x3, p3, t3, (e3 & 8) ? 1.0f : -1.0f, q1 ? SC_B : 1.0f);
        if (lane < 32) *(GAS u32x4*)((q4 ? QA : KA) + (size_t)row * 384 + h4 * 96 + 64 + 8 * c4) = rope_math(x4, p4, t4, (e4 & 8) ? 1.0f : -1.0f, q4 ? rq * SC_A : 1.0f);
        if (lane < 48) { const u32x4 w = rope_math(x5, p5, t5, (e5 & 16) ? 1.0f : -1.0f, q1 ? SC_D : 1.0f);
            if (q1) *(GAS u32x4*)(QD + (size_t)row * 256 + 8 * c5) = w; else *(GAS u32x4*)(KD + (size_t)row * 128 + 8 * c5) = w; }
    }
}

DI void attn_phase(LAS unsigned char* lds, int l, int G) {
    unsigned char* const ws = WSP_;
    const bf16_t* PB = (const bf16_t*)(ws + WS_S + S_P);
    unsigned char* der = ws + WS_S + S_DER;
    const bf16_t *QA = (const bf16_t*)(der + D_QA), *KA = (const bf16_t*)(der + D_KA), *VA = (const bf16_t*)(der + D_VA), *QB = (const bf16_t*)(der + D_QB), *KB = (const bf16_t*)(der + D_KB),
                 *QD = (const bf16_t*)(der + D_QD), *KD = (const bf16_t*)(der + D_KD);
    bf16_t* Y = (bf16_t*)(ws + WS_S + S_Y);
    const float* SCL = (const float*)(ws + WS_TAB) + 128 * 24 * 2;
    const float lam = SCL[2 * l], post = SCL[2 * l + 1];
    const int bx = opaque_bid(); const int vc = (G % 8 == 0) ? ((bx % 8) * (G / 8) + bx / 8) : bx;
    const int nunits = 4096 + (l == 0 ? 128 : 0);
    const float* const subln_l = INP_(16) + l * 64; const float* const rpb_l = INP_(17) + (size_t)l * 4 * 465;
    float sk0, sk1, sk2, sk3; { const GAS float* sp = (const GAS float*)(INP_(18) + l * 4); sk0 = sp[0] * LOG2E; sk1 = sp[1] * LOG2E; sk2 = sp[2] * LOG2E; sk3 = sp[3] * LOG2E; }
    for (int id = vc; id < nunits; id += G) {
        AttnU a; a.m0 = -1e30f; a.l0 = 0.f; a.rpb = nullptr; a.lam = lam; a.post = post; a.subln = subln_l; a.ys = DM;
        int br, b, hh, qb; bool isctx = false;
        if (id < 4096) { br = id >> 10; const int rem = id & 1023; b = rem >> 7; hh = (rem >> 5) & 3; qb = rem & 31; }
        else { const int c = id - 4096; br = c >> 5; b = (c >> 2) & 7; hh = c & 3; qb = 0; isctx = true; }
        const size_t qrow = isctx ? (size_t)(MLAT + b * CTX) : (size_t)(b * SEQ + qb * 256);
        a.b = b; a.q0 = qb * 256; a.lt0 = 0; a.lt1 = isctx ? 0 : 128;
        a.Y = Y + qrow * DM + br * 256 + hh * 64;
        if (br == 0) { a.Q = QA + qrow * 384 + hh * 96; a.qs = 384; a.K = KA + hh * 96; a.ks = 384; a.V = VA + hh * 64; a.vs = 256;
            attn_unit<96, 1, 0>(lds, a); }
        else if (br == 1) { a.Q = QB + qrow * 256 + hh * 64; a.qs = 256; a.K = KB + hh * 64; a.ks = 256; a.V = PB + C_DV + hh * 64; a.vs = INP;
            attn_unit<64, 2, 0>(lds, a); }
        else if (br == 2) { a.Q = PB + qrow * INP + C_NQ + hh * 64; a.qs = INP; a.K = PB + C_NK + hh * 64; a.ks = INP; a.V = PB + C_NV + hh * 64; a.vs = INP;
            if (isctx) attn_unit<64, 1, 0>(lds, a);
            else { const int r0 = qb * 4; int lo = r0 - 4; lo = lo < 0 ? 0 : (lo > 120 ? 120 : lo); int hi = r0 + 3 - 4; hi = hi < 0 ? 0 : (hi > 120 ? 120 : hi);
                a.lt0 = lo; a.lt1 = hi + 8; a.rpb = rpb_l + hh * 465; attn_unit<64, 1, 1>(lds, a); } }
        else { a.Q = QD + qrow * 256 + hh * 64; a.qs = 256; a.K = KD + (hh >> 1) * 64; a.ks = 128; a.V = PB + C_GV + (hh >> 1) * 64; a.vs = INP;
            a.m0 = (hh == 0) ? sk0 : (hh == 1) ? sk1 : (hh == 2) ? sk2 : sk3; a.l0 = 1.0f;
            if (!isctx) { int lo = a.q0 - 128; lo = lo < 0 ? 0 : lo; int hi = a.q0 + 256 + 128; hi = hi > SEQ ? SEQ : hi; a.lt0 = lo >> 6; a.lt1 = hi >> 6; }
            attn_unit<64, 1, 2>(lds, a); }
    }
}


constexpr size_t WS_BAR = WS_TAB + 512 * 1024;
#define XB_TMO      128
#define XB_XCNT(j)  (256  + 64 * (j))
#define XB_XSUB(j)  (1280 + 64 * (j))
#define XB_XGEN(j)  (2304 + 64 * (j))
#define XB_TOP      3328
#define XB_TOPGEN   3392
#define XCD_BAR_WORDS 3456
#define XB_SPIN_CAP (1u << 22)
DI unsigned xb_ld(unsigned* p)              { return __hip_atomic_load(p, __ATOMIC_RELAXED, __HIP_MEMORY_SCOPE_AGENT); }
DI unsigned xb_add(unsigned* p, unsigned v) { return __hip_atomic_fetch_add(p, v, __ATOMIC_RELAXED, __HIP_MEMORY_SCOPE_AGENT); }
DI unsigned xb_xcc_id() { return (unsigned)__builtin_amdgcn_s_getreg((3 << 11) | 20) & 0xFu; }
#define XB_SPIN(cond, bar) do { unsigned _sp = 0; while (cond) { __builtin_amdgcn_s_sleep(1); \
    if ((++_sp & 255u) == 0u) { if (xb_ld(&(bar)[XB_TMO])) break; if (_sp > XB_SPIN_CAP) { atomicAdd(&(bar)[XB_TMO], 1u); break; } } } } while (0)
struct XcdBarrier { unsigned* bar; unsigned x; volatile LAS unsigned* st; };
DI XcdBarrier xcd_barrier_post(unsigned* bar, volatile LAS unsigned* st) {
    XcdBarrier b; b.bar = bar; b.x = xb_xcc_id(); b.st = st;
    if (threadIdx.x == 0) (void)xb_add(&bar[XB_XCNT(b.x)], 1u);
    return b;
}
DI void xcd_barrier_complete(unsigned* bar, unsigned x, unsigned& nloc, unsigned& nx) {
    const unsigned G = gridDim.x * gridDim.y * gridDim.z;
    unsigned sum, cnt, mine, sp = 0u;
    for (;;) {
        sum = 0u; cnt = 0u; mine = 0u;
#pragma unroll
        for (unsigned j = 0; j < 16; ++j) { const unsigned c = xb_ld(&bar[XB_XCNT(j)]); sum += c; cnt += (c > 0u) ? 1u : 0u; mine = (j == x) ? c : mine; }
        if (sum == G) break;
        __builtin_amdgcn_s_sleep(1);
        if ((++sp & 255u) == 0u) { if (xb_ld(&bar[XB_TMO])) break; if (sp > XB_SPIN_CAP) { atomicAdd(&bar[XB_TMO], 1u); break; } }
    }
    nloc = mine > 0u ? mine : 1u; nx = cnt > 0u ? cnt : 1u;
}
DI void xcd_barrier(const XcdBarrier& b) {
    asm volatile("s_waitcnt vmcnt(0)" ::: "memory");
    __syncthreads();
    if (threadIdx.x == 0) {
        unsigned* bar = b.bar; asm volatile("" : "+s"(bar));
        unsigned bx_ = b.x; asm volatile("" : "+s"(bx_));
        __builtin_amdgcn_s_waitcnt(0);
        unsigned nloc = b.st[0], nx = b.st[1];
        if (nloc == 0u) { xcd_barrier_complete(bar, bx_, nloc, nx); b.st[0] = nloc; b.st[1] = nx; }
        const unsigned old = xb_add(&bar[XB_XSUB(bx_)], 1u);
        const unsigned gen = old / nloc;
        if (old + 1u == (gen + 1u) * nloc) {
            __builtin_amdgcn_fence(__ATOMIC_RELEASE, "agent");
            asm volatile("s_waitcnt vmcnt(0)" ::: "memory");
            const unsigned og = xb_add(&bar[XB_TOP], 1u);
            const unsigned tg = og / nx;
            if (og + 1u == (tg + 1u) * nx) xb_add(&bar[XB_TOPGEN], 1u);
            else XB_SPIN(xb_ld(&bar[XB_TOPGEN]) == tg, bar);
            __builtin_amdgcn_fence(__ATOMIC_ACQUIRE, "agent");
            xb_add(&bar[XB_XGEN(bx_)], 1u);
            asm volatile("s_waitcnt vmcnt(0)" ::: "memory");
        } else {
            XB_SPIN(xb_ld(&bar[XB_XGEN(bx_)]) == gen, bar);
            __builtin_amdgcn_fence(__ATOMIC_ACQUIRE, "agent");
            asm volatile("s_waitcnt vmcnt(0)" ::: "memory");
        }
    }
    __syncthreads();
}

constexpr int LDS_BYTES = 136 * 1024;
constexpr int STEPS_PER_LAYER = 20, NSTEPS = 2 * STEPS_PER_LAYER + 1;

__global__ void __launch_bounds__(NTHR, 2) mega_fwd(Params P) {
    extern __shared__ __attribute__((aligned(16))) unsigned char lds_raw[];
    LAS unsigned char* lds = (LAS unsigned char*)lds_raw;
    cg::grid_group grid = cg::this_grid();
    const int G = gridDim.x;
    {
        volatile LAS unsigned long long* tab = (volatile LAS unsigned long long*)(lds + CTLO); const int t = threadIdx.x;
#define TAB_(k) if (t == (k)) tab[k] = (unsigned long long)P.in[k];
        TAB_(0) TAB_(1) TAB_(2) TAB_(3) TAB_(4) TAB_(5) TAB_(6) TAB_(7) TAB_(8) TAB_(9) TAB_(10) TAB_(11) TAB_(12) TAB_(13) TAB_(14) TAB_(15) TAB_(16) TAB_(17) TAB_(18) TAB_(19)
        TAB_(20) TAB_(21) TAB_(22) TAB_(23) TAB_(24) TAB_(25) TAB_(26)
#undef TAB_
        if (t == 27) tab[27] = (unsigned long long)P.out;
        if (t == 28) tab[28] = (unsigned long long)P.ws;
        if (t == 29) { volatile LAS unsigned* st = (volatile LAS unsigned*)(lds + CTLO + 512); st[0] = 0u; st[1] = 0u; }
    }
    __syncthreads();
    const XcdBarrier xbar = xcd_barrier_post((unsigned*)(P.ws + WS_BAR), (volatile LAS unsigned*)(lds + CTLO + 512));

    prologue_phase(lds, G);
    grid.sync();

    bool skip_nm = false;
    for (int st = 0; st < NSTEPS; ++st) {
        unsigned char* const ws = WSP_;
        float* const H = OUTP_; float* const HC = (float*)(ws + WS_HC);
        bf16_t* const U = (bf16_t*)(ws + WS_U);
        bf16_t* const FFH = (bf16_t*)(ws + WS_S + S_FFH); bf16_t* const PBUF = (bf16_t*)(ws + WS_S + S_P); bf16_t* const RBUF = (bf16_t*)(ws + WS_S + S_R);
        bf16_t* const YB = (bf16_t*)(ws + WS_S + S_Y); bf16_t* const BRB = (bf16_t*)(ws + WS_S + S_BR); bf16_t* const MG = (bf16_t*)(ws + WS_S + S_MG);
        if (st == NSTEPS - 1) { final_phase(H, INP_(26), G); break; }
        const int l = st / STEPS_PER_LAYER, j = st % STEPS_PER_LAYER;
        const unsigned char* wl = ws + WS_W + (size_t)l * WL;
        const float* modl = (const float*)(ws + WS_MOD) + (size_t)l * 9 * 9216;
        const bool last = (l == 1);
        const int Mpost = last ? MLAT : MALL;
        bool is_gemm = false; pg8::Gemm g{}; pg8::Epi E{}; int M = MALL;
        const bool nm_skipped = skip_nm && (j == 0 || j == 3 || j == 17); if (nm_skipped) skip_nm = false;
        switch (nm_skipped ? 99 : j) {
        case 0: {
            const float* sl = (l == 0) ? INP_(0) : H; const float* sc = (l == 0) ? INP_(2) : HC;
            nm_phase(sl, sc, INP_(6) + l * DM, modl, 0, 1, U, MALL, G); break; }
        case 1: case 18: {
            is_gemm = true; M = (j == 1) ? MALL : Mpost; g = pg8::Gemm{U, (const bf16_t*)(wl + (j == 1 ? W_GU1 : W_GU2)), M, 2 * DFF, DM, DM};
            E.mode = 1; E.perm = true; E.O = FFH; E.ldc = DFF; break; }
        case 2: case 19: {
            is_gemm = true; M = (j == 2) ? MALL : Mpost; g = pg8::Gemm{FFH, (const bf16_t*)(wl + (j == 2 ? W_DN1 : W_DN2)), M, DM, DFF, DFF};
            E.mode = 2; E.perm = false; const bool first = (l == 0 && j == 2);
            E.base_lat = first ? INP_(0) : H; E.base_ctx = first ? INP_(2) : HC; E.out_lat = H; E.out_ctx = HC; E.modp = modl; E.gate_chunk = (j == 2) ? 2 : 8; E.gs = 0.5f; break; }
        case 3: nm_phase(H, HC, INP_(9) + l * DM, modl, 3, 4, U, MALL, G); break;
        case 4: { is_gemm = true; M = MALL; g = pg8::Gemm{U, (const bf16_t*)(wl + W_IN), M, INP, DM, DM}; E.mode = 0; E.perm = true; E.O = PBUF; E.ldc = INP; break; }
        case 5: { is_gemm = true; M = MALL; g = pg8::Gemm{PBUF, (const bf16_t*)(wl + W_MLA), M, 1024, 384, INP}; E.mode = 0; E.perm = true; E.O = RBUF; E.ldc = DM; break; }
        case 6: derive_phase(lds, G); break;
        case 7: attn_phase(lds, l, G); break;
        case 8: case 10: case 12: case 14: { const int i = (j - 8) >> 1;
            is_gemm = true; M = Mpost; g = pg8::Gemm{YB + 256 * i, (const bf16_t*)(wl + W_BR) + (size_t)i * DM * 256, M, DM, 256, DM}; E.mode = 0; E.perm = true; E.O = BRB; E.ldc = DM; break; }
        case 9: case 11: case 13: case 15: { const int i = (j - 9) >> 1;
            is_gemm = true; M = Mpost; g = pg8::Gemm{U, (const bf16_t*)(wl + W_GATE) + (size_t)i * DM * DM, M, DM, DM, DM};
            E.mode = 3; E.perm = true; E.bias = INP_(21) + ((size_t)l * 4 + i) * DM; E.BR = BRB; E.MG = MG; E.gi = i; break; }
        case 16: { is_gemm = true; M = Mpost; g = pg8::Gemm{BRB, (const bf16_t*)(wl + W_OUT), M, DM, DM, DM};
            E.mode = 2; E.perm = false; E.base_lat = H; E.base_ctx = HC; E.out_lat = H; E.out_ctx = HC; E.modp = modl; E.gate_chunk = 5; E.gs = 1.0f; break; }
        case 17: nm_phase(H, HC, INP_(23) + l * DM, modl, 6, 7, U, Mpost, G); break;
        default: break;
        }
        const bool split = is_gemm && E.mode == 2 && M == MALL && G > 64;
        const int nsub = split ? 2 : 1;
        const bool eperm = E.perm;
        if (is_gemm) {
            E.row_off = 0;
            if (threadIdx.x == 0) { pg8::epi_store(lds, E);
                volatile LAS unsigned long long* gq = (volatile LAS unsigned long long*)(lds + CTL_EPI + 128);
                gq[0] = (unsigned long long)g.A; gq[1] = (unsigned long long)g.Bt; gq[2] = ((unsigned long long)(unsigned)g.N << 32) | (unsigned)g.K; gq[3] = ((unsigned long long)(unsigned)M << 32) | (unsigned)g.lda; }
        }
        for (int sub = 0; sub < nsub; ++sub) {
            if (is_gemm) {
                if (split && sub == 1 && threadIdx.x == 0) ((volatile LAS pg8::EpiL*)(lds + CTL_EPI))->row_off = (unsigned)MLAT;
                __syncthreads();
                pg8::Gemm gs; { const unsigned long long nk = lds_u64(lds, CTL_EPI + 128 + 16), ml = lds_u64(lds, CTL_EPI + 128 + 24);
                    gs.A = (const bf16_t*)lds_u64(lds, CTL_EPI + 128); gs.Bt = (const bf16_t*)lds_u64(lds, CTL_EPI + 128 + 8); gs.N = (int)(nk >> 32); gs.K = (int)(unsigned)nk; gs.M = (int)(ml >> 32); gs.lda = (int)(unsigned)ml; }
                if (split) { if (sub == 0) gs.M = MLAT; else { gs.A = gs.A + (size_t)MLAT * gs.lda; gs.M = MCTX; } }
                pg8::StaticOrder S; S.init(gs.M, gs.N, G, (int)blockIdx.x); pg8::gemm_phase(lds, gs, S, eperm);
                if (l == 0 && j == 15) conv_tail_fill(lds, G); }
            if (split) {
                const float* ngain; const float* nmod; int nsh, nsc;
                if (j == 2) { ngain = INP_(9) + l * DM; nmod = modl; nsh = 3; nsc = 4; }
                else if (j == 16) { ngain = INP_(23) + l * DM; nmod = modl; nsh = 6; nsc = 7; }
                else { ngain = INP_(6) + (l + 1) * DM; nmod = modl + 9 * 9216; nsh = 0; nsc = 1; }
                if (sub == 0) xcd_barrier(xbar);
                else { nm_phase(H, HC, ngain, nmod, nsh, nsc, U, MLAT, G, 0, 32);
                       xcd_barrier(xbar);
                       nm_phase(H, HC, ngain, nmod, nsh, nsc, U, MALL, G, MLAT, 0);
                       skip_nm = true; }
            }
        }
        const bool nosync = (j >= 8 && j <= 14) || nm_skipped;
        if (!nosync) xcd_barrier(xbar);
    }
}

extern "C" void kernel_launch(void* const* d_in, const int* in_sizes, int n_in, void* d_out, int out_size, void* d_ws, size_t ws_size, hipStream_t stream) {
    static int grid_blocks = 0;
    if (grid_blocks == 0) {
        if (n_in != 27 || ws_size < WS_END) { fprintf(stderr, "kernel_launch: unexpected inputs (n_in %d, ws %zu < %zu)\n", n_in, ws_size, (size_t)WS_END); grid_blocks = -1; return; }
        int dev = 0, cus = 0, per_cu = 0;
        hipGetDevice(&dev);
        hipDeviceGetAttribute(&cus, hipDeviceAttributeMultiprocessorCount, dev);
        hipFuncSetAttribute((const void*)mega_fwd, hipFuncAttributeMaxDynamicSharedMemorySize, LDS_BYTES);
        hipOccupancyMaxActiveBlocksPerMultiprocessor(&per_cu, (const void*)mega_fwd, NTHR, LDS_BYTES);
        if (per_cu < 1) { fprintf(stderr, "kernel_launch: occupancy query returned %d\n", per_cu); per_cu = 1; }
        grid_blocks = cus * 1;
        (void)hipGetLastError();
    }
    if (grid_blocks < 0) return;
    Params p{};
    for (int i = 0; i < 27; ++i) p.in[i] = (const float*)d_in[i];
    p.out = (float*)d_out; p.ws = (unsigned char*)d_ws;
    (void)hipMemsetAsync((unsigned char*)d_ws + WS_BAR, 0, XCD_BAR_WORDS * 4, stream);
    void* args[] = {&p};
    hipError_t e = hipLaunchCooperativeKernel((const void*)mega_fwd, dim3(grid_blocks), dim3(NTHR), args, LDS_BYTES, stream);
    if (e != hipSuccess) fprintf(stderr, "cooperative launch failed: %s (grid %d)\n", hipGetErrorString(e), grid_blocks);
}
```
